# Optimizing an MI355X kernel written in HIP

```python
import math
import jax
import jax.numpy as jnp
from jax import lax
import numpy as np

D_MODEL = 2048
BATCH = 4
SEQ = 4096
DEPTH = 2
DEC_BATCH = 16
DEC_SEQ = 16
PAST_LEN = 2048

CHUNK = 64
N_BRANCH = 4
BRANCH_W = D_MODEL // 4
CONV_WIDTH = 3
CONV_DIM = BRANCH_W
RET_HEADS = 4
RET_DK = BRANCH_W // RET_HEADS
RET_DV = BRANCH_W // RET_HEADS
DIFF_HEADS = 4
DIFF_D = BRANCH_W // (2 * DIFF_HEADS)
DIFF_DV = 2 * DIFF_D
MEM_TOKENS = 256
MEM_HEADS = 4
MEM_HD = BRANCH_W // MEM_HEADS
D_FF = 11 * D_MODEL // 4
REL_BUCKETS = 32
REL_MAX_DIST = 128
Q_BLOCK = 128
LN_EPS = 1e-5
ROPE_BASE = 10000.0
NEG_INF = -1e30
DEEPNORM_ALPHA = (2 * DEPTH) ** 0.25
DEEPNORM_BETA = (8 * DEPTH) ** -0.25
IN_SPLITS = (CONV_DIM, CONV_DIM, CONV_DIM,
             RET_HEADS * RET_DK, RET_HEADS * RET_DK, RET_HEADS * RET_DV, RET_HEADS * RET_DV,
             DIFF_HEADS * 2 * DIFF_D, DIFF_HEADS * 2 * DIFF_D, DIFF_HEADS * DIFF_DV,
             MEM_HEADS * MEM_HD)
IN_COLS = sum(IN_SPLITS)

kernel_name = 'hybrid_stream_encoder_step'

F32 = jnp.float32


def layer_norm(x, g, b):
    x32 = x.astype(F32)
    mu = jnp.mean(x32, -1, keepdims=True)
    var = jnp.mean(jnp.square(x32 - mu), -1, keepdims=True)
    return ((x32 - mu) * lax.rsqrt(var + LN_EPS) * g.astype(F32) + b.astype(F32)).astype(x.dtype)


def rms_norm(x, g):
    x32 = x.astype(F32)
    return x32 * lax.rsqrt(jnp.mean(jnp.square(x32), -1, keepdims=True) + LN_EPS) * g.astype(F32)


def head_norm(x, g):
    mu = jnp.mean(x, -1, keepdims=True)
    var = jnp.mean(jnp.square(x - mu), -1, keepdims=True)
    return (x - mu) * lax.rsqrt(var + LN_EPS) * g.astype(F32)


def swiglu(x, w_up, w_down):
    a, b = jnp.split(x @ w_up, 2, axis=-1)
    return (jax.nn.silu(a) * b) @ w_down


def split_cols(x, sizes):
    out, start = [], 0
    for s in sizes:
        out.append(x[..., start:start + s])
        start += s
    return out


def rope(x, pos):
    half = x.shape[-1] // 2
    inv = ROPE_BASE ** (-jnp.arange(half, dtype=F32) / half)
    ang = pos.astype(F32)[:, None] * inv[None, :]
    cos = jnp.cos(ang)[None, :, None, :]
    sin = jnp.sin(ang)[None, :, None, :]
    x1 = x[..., :half].astype(F32)
    x2 = x[..., half:].astype(F32)
    return jnp.concatenate([x1 * cos - x2 * sin, x2 * cos + x1 * sin], -1).astype(x.dtype)


def t5_bucket(rel):
    nb = REL_BUCKETS // 2
    max_exact = nb // 2
    n = jnp.abs(rel)
    nf = jnp.maximum(n, 1).astype(F32)
    large = max_exact + (jnp.log(nf / max_exact) / math.log(REL_MAX_DIST / max_exact)
                         * (nb - max_exact)).astype(jnp.int32)
    large = jnp.minimum(large, nb - 1)
    return jnp.where(rel > 0, nb, 0) + jnp.where(n < max_exact, n, large)


def short_conv_branch(b_gate, c_gate, h, conv_w, conv_prev):
    u = c_gate * h
    bsz, length, _ = u.shape
    if conv_prev is None:
        prev = jnp.zeros((bsz, CONV_WIDTH - 1, CONV_DIM), u.dtype)
    else:
        prev = conv_prev.astype(u.dtype)
    up = jnp.concatenate([prev, u], axis=1)
    z = sum(conv_w[j] * up[:, j:j + length] for j in range(CONV_WIDTH))
    return b_gate * z, up[:, length:]


def retention(q, k, v, s0):
    bsz, length, heads, _ = q.shape
    dv = v.shape[-1]
    c = CHUNK if length % CHUNK == 0 else length
    n = length // c
    log_g = jnp.log1p(-jnp.exp2(-5.0 - jnp.arange(heads, dtype=F32)))
    idx = jnp.arange(c, dtype=F32)
    rel = idx[:, None] - idx[None, :]
    intra = jnp.where(rel[None] >= 0, jnp.exp(jnp.maximum(rel, 0.0)[None] * log_g[:, None, None]), 0.0)
    q_dec = jnp.exp((idx[:, None] + 1.0) * log_g[None, :])
    k_dec = jnp.exp((c - 1.0 - idx)[:, None] * log_g[None, :])
    c_dec = jnp.exp(c * log_g)

    def to_chunks(t):
        return jnp.moveaxis(t.astype(F32).reshape(bsz, n, c, heads, t.shape[-1]), 1, 0)

    def step(s, xs):
        qc, kc, vc = xs
        att = jnp.einsum('bihd,bjhd->bhij', qc, kc) * intra
        o = (jnp.einsum('bhij,bjhe->bihe', att, vc)
             + jnp.einsum('bihd,bhde->bihe', qc, s) * q_dec[None, :, :, None])
        s = s * c_dec[:, None, None] + jnp.einsum('bjhd,bjhe->bhde', kc * k_dec[None, :, :, None], vc)
        return s, o

    s_fin, o = lax.scan(step, s0.astype(F32), (to_chunks(q), to_chunks(k), to_chunks(v)))
    return jnp.moveaxis(o, 0, 1).reshape(bsz, length, heads, dv), s_fin


def diff_attend(q, k, v, q_pos, k_pos, rel_bias, lam):
    s = jnp.einsum('bqhcd,bkhcd->bchqk', q, k).astype(F32) * (DIFF_D ** -0.5)
    bias = jnp.transpose(rel_bias[t5_bucket(k_pos[None, :] - q_pos[:, None])], (2, 0, 1)).astype(F32)
    allowed = (k_pos[None, :] // CHUNK) <= (q_pos[:, None] // CHUNK)
    s = jnp.where(allowed, s + bias, NEG_INF)
    p = jax.nn.softmax(s, axis=-1)
    a = p[:, 0] - lam * p[:, 1]
    return jnp.einsum('bhqk,bkhe->bqhe', a.astype(v.dtype), v)


def diff_attention(q, k, v, q_pos, k_pos, rel_bias, lam):
    bsz, sq = q.shape[:2]
    if sq <= Q_BLOCK or sq % Q_BLOCK:
        return diff_attend(q, k, v, q_pos, k_pos, rel_bias, lam)
    nb = sq // Q_BLOCK
    qb = jnp.moveaxis(q.reshape((bsz, nb, Q_BLOCK) + q.shape[2:]), 1, 0)
    pb = q_pos.reshape(nb, Q_BLOCK)
    ob = lax.map(lambda a: diff_attend(a[0], k, v, a[1], k_pos, rel_bias, lam), (qb, pb))
    return jnp.moveaxis(ob, 0, 1).reshape((bsz, sq) + ob.shape[3:])


def mem_attention(q, mk, mv):
    s = jnp.einsum('bqhd,bkhd->bhqk', q, mk).astype(F32) * (MEM_HD ** -0.5)
    p = jax.nn.softmax(s, axis=-1)
    return jnp.einsum('bhqk,bkhd->bqhd', p.astype(mv.dtype), mv)


def memory_kv(mem, w_mem_kv):
    k, v = jnp.split(mem @ w_mem_kv, 2, axis=-1)
    shape = mem.shape[:2] + (MEM_HEADS, MEM_HD)
    return k.reshape(shape), v.reshape(shape)


def token_mixer(h, pos, layer_idx, lw, rel_bias, conv_prev, ret_prev, k_past, v_past, past_pos, mem_k, mem_v):
    bsz, length, _ = h.shape
    (cb, cc, ch, rq, rk, rv, rg, dq, dk, dv, mq) = split_cols(h @ lw['w_in'], IN_SPLITS)
    y_a, conv_new = short_conv_branch(cb, cc, ch, lw['conv_w'], conv_prev)
    rq = rope(rq.reshape(bsz, length, RET_HEADS, RET_DK), pos)
    rk = rope(rk.reshape(bsz, length, RET_HEADS, RET_DK), pos) * (RET_DK ** -0.5)
    rv = rv.reshape(bsz, length, RET_HEADS, RET_DV)
    s0 = jnp.zeros((bsz, RET_HEADS, RET_DK, RET_DV), F32) if ret_prev is None else ret_prev
    ro, ret_new = retention(rq, rk, rv, s0)
    ro = head_norm(ro, lw['ret_gn_g'].reshape(RET_HEADS, RET_DV))
    y_b = jax.nn.silu(rg) * ro.reshape(bsz, length, RET_HEADS * RET_DV).astype(h.dtype)
    dk_rows = dk.reshape(bsz, length, DIFF_HEADS, 2 * DIFF_D)
    dv_rows = dv.reshape(bsz, length, DIFF_HEADS, DIFF_DV)
    if k_past is None:
        k_all, v_all, k_pos = dk_rows, dv_rows, pos
    else:
        k_all = jnp.concatenate([k_past.astype(dk_rows.dtype), dk_rows], axis=1)
        v_all = jnp.concatenate([v_past.astype(dv_rows.dtype), dv_rows], axis=1)
        k_pos = jnp.concatenate([past_pos, pos])
    lam_init = 0.8 - 0.6 * math.exp(-0.3 * layer_idx)
    lp = lw['diff_lambda'].astype(F32)
    lam = jnp.exp(jnp.sum(lp[0] * lp[1])) - jnp.exp(jnp.sum(lp[2] * lp[3])) + lam_init
    do = diff_attention(dq.reshape(bsz, length, DIFF_HEADS, 2, DIFF_D),
                        k_all.reshape(bsz, -1, DIFF_HEADS, 2, DIFF_D), v_all,
                        pos, k_pos, rel_bias, lam)
    do = rms_norm(do, lw['diff_subln_g']) * (1.0 - lam_init)
    y_c = do.reshape(bsz, length, DIFF_HEADS * DIFF_DV).astype(h.dtype)
    y_d = mem_attention(mq.reshape(bsz, length, MEM_HEADS, MEM_HD), mem_k, mem_v).reshape(bsz, length, BRANCH_W)
    merged = 0
    for i, y in enumerate((y_a, y_b, y_c, y_d)):
        merged = merged + jax.nn.sigmoid(h @ lw['w_gate'][i] + lw['b_gate'][i]) * (y @ lw['w_branch'][i])
    return merged @ lw['w_o'], (conv_new, ret_new, dk_rows, dv_rows)


def encoder_layer(x, pos, layer_idx, lw, rel_bias, conv_prev, ret_prev, k_past, v_past, past_pos, mem_k, mem_v):
    x = layer_norm(DEEPNORM_ALPHA * x + 0.5 * swiglu(x, lw['ffn1_w_up'], lw['ffn1_w_down']), lw['ln1_g'], lw['ln1_b'])
    mix, new_state = token_mixer(x, pos, layer_idx, lw, rel_bias, conv_prev, ret_prev, k_past, v_past, past_pos, mem_k, mem_v)
    x = layer_norm(DEEPNORM_ALPHA * x + mix, lw['ln2_g'], lw['ln2_b'])
    x = layer_norm(DEEPNORM_ALPHA * x + 0.5 * swiglu(x, lw['ffn2_w_up'], lw['ffn2_w_down']), lw['ln3_g'], lw['ln3_b'])
    return x, new_state


def setup_inputs(seed: int = 0) -> dict:
    key = jax.random.key(seed)
    ks = jax.random.split(key, 32)
    beta = DEEPNORM_BETA

    def nrm(k, shape, scale):
        return jax.random.normal(k, shape, F32) * scale

    return {
        'x_prompt': nrm(ks[0], (BATCH, SEQ, D_MODEL), 1.0),
        'x_sample': nrm(ks[1], (DEC_BATCH, DEC_SEQ, D_MODEL), 1.0),
        'state_conv': nrm(ks[2], (DEPTH, DEC_BATCH, CONV_WIDTH - 1, CONV_DIM), 1.0),
        'state_ret': nrm(ks[3], (DEPTH, DEC_BATCH, RET_HEADS, RET_DK, RET_DV), 1.0),
        'cache_diff_k': nrm(ks[4], (DEPTH, DEC_BATCH, PAST_LEN, DIFF_HEADS, 2 * DIFF_D), 1.0),
        'cache_diff_v': nrm(ks[5], (DEPTH, DEC_BATCH, PAST_LEN, DIFF_HEADS, DIFF_DV), 1.0),
        'cache_mem_k': nrm(ks[6], (DEPTH, DEC_BATCH, MEM_TOKENS, MEM_HEADS, MEM_HD), 1.0),
        'cache_mem_v': nrm(ks[7], (DEPTH, DEC_BATCH, MEM_TOKENS, MEM_HEADS, MEM_HD), 1.0),
        'mem_prompt': nrm(ks[8], (BATCH, MEM_TOKENS, D_MODEL), 1.0),
        'ffn1_w_up': nrm(ks[9], (DEPTH, D_MODEL, 2 * D_FF), beta * D_MODEL ** -0.5),
        'ffn1_w_down': nrm(ks[10], (DEPTH, D_FF, D_MODEL), beta * D_FF ** -0.5),
        'ln1_g': 1.0 + nrm(ks[11], (DEPTH, D_MODEL), 0.02),
        'ln1_b': nrm(ks[12], (DEPTH, D_MODEL), 0.02),
        'w_in': nrm(ks[13], (DEPTH, D_MODEL, IN_COLS), D_MODEL ** -0.5),
        'conv_w': nrm(ks[14], (DEPTH, CONV_WIDTH, CONV_DIM), CONV_WIDTH ** -0.5),
        'ret_gn_g': 1.0 + nrm(ks[15], (DEPTH, RET_HEADS * RET_DV), 0.02),
        'diff_lambda': nrm(ks[16], (DEPTH, 4, DIFF_D), 0.1),
        'diff_subln_g': 1.0 + nrm(ks[17], (DEPTH, DIFF_DV), 0.02),
        'w_mem_kv': nrm(ks[18], (DEPTH, D_MODEL, 2 * MEM_HEADS * MEM_HD), D_MODEL ** -0.5),
        'w_branch': nrm(ks[19], (DEPTH, N_BRANCH, BRANCH_W, D_MODEL), beta * BRANCH_W ** -0.5),
        'w_gate': nrm(ks[20], (DEPTH, N_BRANCH, D_MODEL, D_MODEL), D_MODEL ** -0.5),
        'b_gate': nrm(ks[21], (DEPTH, N_BRANCH, D_MODEL), 0.02),
        'w_o': nrm(ks[22], (DEPTH, D_MODEL, D_MODEL), beta * D_MODEL ** -0.5),
        'ln2_g': 1.0 + nrm(ks[23], (DEPTH, D_MODEL), 0.02),
        'ln2_b': nrm(ks[24], (DEPTH, D_MODEL), 0.02),
        'ffn2_w_up': nrm(ks[25], (DEPTH, D_MODEL, 2 * D_FF), beta * D_MODEL ** -0.5),
        'ffn2_w_down': nrm(ks[26], (DEPTH, D_FF, D_MODEL), beta * D_FF ** -0.5),
        'ln3_g': 1.0 + nrm(ks[27], (DEPTH, D_MODEL), 0.02),
        'ln3_b': nrm(ks[28], (DEPTH, D_MODEL), 0.02),
        'rel_bias': nrm(ks[29], (REL_BUCKETS, DIFF_HEADS), 0.5),
    }


def reference(x_prompt, x_sample, state_conv, state_ret, cache_diff_k, cache_diff_v, cache_mem_k, cache_mem_v,
              mem_prompt, ffn1_w_up, ffn1_w_down, ln1_g, ln1_b, w_in, conv_w, ret_gn_g, diff_lambda,
              diff_subln_g, w_mem_kv, w_branch, w_gate, b_gate, w_o, ln2_g, ln2_b, ffn2_w_up, ffn2_w_down,
              ln3_g, ln3_b, rel_bias):
    pos_p = jnp.arange(SEQ, dtype=jnp.int32)
    pos_s = PAST_LEN + jnp.arange(DEC_SEQ, dtype=jnp.int32)
    past_pos = jnp.arange(PAST_LEN, dtype=jnp.int32)
    yp, ys = x_prompt, x_sample
    conv_p, ret_p, dk_p, dv_p, mk_p, mv_p = [], [], [], [], [], []
    conv_s, ret_s, dk_s, dv_s = [], [], [], []
    for l in range(DEPTH):
        lw = {
            'ffn1_w_up': ffn1_w_up[l], 'ffn1_w_down': ffn1_w_down[l], 'ln1_g': ln1_g[l], 'ln1_b': ln1_b[l],
            'w_in': w_in[l], 'conv_w': conv_w[l], 'ret_gn_g': ret_gn_g[l], 'diff_lambda': diff_lambda[l],
            'diff_subln_g': diff_subln_g[l], 'w_branch': w_branch[l], 'w_gate': w_gate[l], 'b_gate': b_gate[l],
            'w_o': w_o[l], 'ln2_g': ln2_g[l], 'ln2_b': ln2_b[l], 'ffn2_w_up': ffn2_w_up[l],
            'ffn2_w_down': ffn2_w_down[l], 'ln3_g': ln3_g[l], 'ln3_b': ln3_b[l],
        }
        mk, mv = memory_kv(mem_prompt, w_mem_kv[l])
        yp, (c_new, r_new, k_new, v_new) = encoder_layer(yp, pos_p, l, lw, rel_bias, None, None, None, None,
                                                         None, mk, mv)
        conv_p.append(c_new)
        ret_p.append(r_new)
        dk_p.append(k_new)
        dv_p.append(v_new)
        mk_p.append(mk)
        mv_p.append(mv)
        ys, (c_new, r_new, k_new, v_new) = encoder_layer(ys, pos_s, l, lw, rel_bias, state_conv[l], state_ret[l],
                                                         cache_diff_k[l], cache_diff_v[l], past_pos,
                                                         cache_mem_k[l], cache_mem_v[l])
        conv_s.append(c_new)
        ret_s.append(r_new)
        dk_s.append(k_new)
        dv_s.append(v_new)
    return (yp, ys, jnp.stack(conv_p), jnp.stack(ret_p), jnp.stack(dk_p), jnp.stack(dv_p), jnp.stack(mk_p),
            jnp.stack(mv_p), jnp.stack(conv_s), jnp.stack(ret_s), jnp.stack(dk_s), jnp.stack(dv_s))
```

```cpp
#include <hip/hip_runtime.h>
#include <cstdio>
#include <cstdint>

#define GAS __attribute__((address_space(1)))
#define LAS __attribute__((address_space(3)))
typedef unsigned short bf16;
typedef short bf16x8 __attribute__((ext_vector_type(8)));
typedef float f32x2 __attribute__((ext_vector_type(2)));
typedef float f32x4 __attribute__((ext_vector_type(4)));
typedef float f32x16 __attribute__((ext_vector_type(16)));
typedef unsigned u32x2 __attribute__((ext_vector_type(2)));
typedef unsigned u32x4 __attribute__((ext_vector_type(4)));
typedef __bf16 bf16v2 __attribute__((ext_vector_type(2)));
typedef GAS unsigned gu32;
#define DI __device__ __forceinline__
#define RLX_AGENT __ATOMIC_RELAXED, __HIP_MEMORY_SCOPE_AGENT

constexpr int D = 2048, FF = 5632, NUP = 2 * FF, NIN = 5632, NGATE = 8192, NIG = NIN + NGATE;
constexpr int MP = 16384, MS = 256, M = MP + MS;
constexpr int SEQ = 4096, PAST = 2048, DSEQ = 16;
constexpr int C_CB = 0, C_CC = 512, C_CH = 1024, C_RQ = 1536, C_RK = 2048, C_RV = 2560, C_RG = 3072, C_DQ = 3584, C_DK = 4096, C_DV = 4608, C_MQ = 5120;
constexpr float LN_EPS = 1e-5f;
constexpr float ALPHA = 1.4142135623730951f;
constexpr float LOG2E = 1.4426950408889634f;
constexpr size_t O_YP = 0, O_YS = O_YP + (size_t)MP * D, O_CONVP = O_YS + (size_t)MS * D, O_RETP = O_CONVP + 2 * 4 * 2 * 512,
                 O_DKP = O_RETP + 2 * 4 * 4 * 128 * 128, O_DVP = O_DKP + (size_t)2 * MP * 512, O_MKP = O_DVP + (size_t)2 * MP * 512,
                 O_MVP = O_MKP + 2 * 1024 * 512, O_CONVS = O_MVP + 2 * 1024 * 512, O_RETS = O_CONVS + 2 * 16 * 2 * 512,
                 O_DKS = O_RETS + 2 * 16 * 4 * 128 * 128, O_DVS = O_DKS + 2 * 256 * 512, O_END = O_DVS + 2 * 256 * 512;

constexpr size_t MiB = 1u << 20;
constexpr size_t WS_CTL = 0, CTL_ZERO_BYTES = 1 * MiB;
constexpr size_t WS_ROPE = 1 * MiB;
constexpr size_t WS_MEMX = 3 * MiB;
constexpr size_t WS_MEMKV = 7 * MiB;
constexpr size_t WS_W = 16 * MiB;
constexpr size_t W_UP1 = 0, W_DN1 = W_UP1 + (size_t)NUP * D * 2, W_IG = W_DN1 + (size_t)D * FF * 2, W_MKV = W_IG + (size_t)NIG * D * 2,
                 W_BR = W_MKV + (size_t)1024 * D * 2, W_WO = W_BR + (size_t)D * D * 2, W_UP2 = W_WO + (size_t)D * D * 2, W_DN2 = W_UP2 + (size_t)NUP * D * 2,
                 LAYER_W = W_DN2 + (size_t)D * FF * 2;
constexpr size_t WS_XA = WS_W + 2 * LAYER_W;
constexpr size_t WS_XB = WS_XA + (size_t)M * D * 4;
constexpr size_t WS_G = WS_XB + (size_t)M * D * 2;
constexpr size_t WS_GATE = WS_G + (size_t)M * FF * 2;
constexpr size_t WS_Y = WS_GATE + (size_t)M * NGATE * 2;
constexpr size_t WS_RETS = WS_Y + (size_t)M * D * 2;
constexpr size_t WS_SLAB = WS_RETS + (size_t)1024 * 128 * 128 * 2;
constexpr size_t WS_VT = WS_SLAB + (size_t)16 * 256 * D * 4;
constexpr size_t WS_BRS = WS_VT + (size_t)16 * 128 * 4096 * 2;
constexpr size_t WS_END = WS_BRS + (size_t)4 * 256 * D * 2;
static_assert(LAYER_W == (size_t)216006656, "layer weights");
static_assert((size_t)1024 * 128 * 128 * 4 <= (size_t)M * D * 4, "RETKV fits its region");
constexpr int CW_BAR = 4096;
constexpr int CW_WQ = 16384;

constexpr int LDS_SCRATCH = 139264;
constexpr int AUX_OFF = LDS_SCRATCH;
constexpr int AUX_ML = 0, AUX_BIAS = 2048, AUX_MISC = 3072;
constexpr int LDS_BYTES = 147456;

DI unsigned pk2(float lo, float hi) { f32x2 v = {lo, hi}; return __builtin_bit_cast(unsigned, __builtin_convertvector(v, bf16v2)); }
DI float bf_lo(unsigned u) { return __uint_as_float(u << 16); }
DI float bf_hi(unsigned u) { return __uint_as_float(u & 0xffff0000u); }
DI float bf2f(bf16 b) { return __uint_as_float(((unsigned)b) << 16); }
DI float fexp2(float x) { return __builtin_amdgcn_exp2f(x); }
DI float frcp(float x) { return __builtin_amdgcn_rcpf(x); }
DI float sigmoidf_(float x) { return frcp(1.0f + fexp2(-x * LOG2E)); }
DI float siluf_(float x) { return x * sigmoidf_(x); }
DI u32x4 pack8(const float* v) { u32x4 w; w.x = pk2(v[0], v[1]); w.y = pk2(v[2], v[3]); w.z = pk2(v[4], v[5]); w.w = pk2(v[6], v[7]); return w; }
DI void unpack8(u32x4 w, float* v) { v[0] = bf_lo(w.x); v[1] = bf_hi(w.x); v[2] = bf_lo(w.y); v[3] = bf_hi(w.y); v[4] = bf_lo(w.z); v[5] = bf_hi(w.z); v[6] = bf_lo(w.w); v[7] = bf_hi(w.w); }
DI float wave_sum(float v) {
#pragma unroll
    for (int o = 1; o < 64; o <<= 1) v += __shfl_xor(v, o);
    return v;
}
#define LDS_WAIT() asm volatile("s_waitcnt lgkmcnt(0)" ::: "memory")
#define VM_WAIT() asm volatile("s_waitcnt vmcnt(0)" ::: "memory")

namespace pg8 {
#define PG8_LAS __attribute__((address_space(3)))
typedef unsigned short bf16_t;
constexpr int BM = 256, BK = 64, HALF = 128, HTB = HALF * BK * 2, STAGE_BYTES = 8 * HTB, NXCD = 8, WGM = 8;
__host__ __device__ __forceinline__ int lds_byte(int r, int c) { const int st = (r >> 4) * 2 + (c >> 5), rr = r & 15, cc = c & 31, ob = rr * 64 + cc * 2; return st * 1024 + (ob ^ (((ob >> 9) & 1) << 5)); }
__host__ __device__ __forceinline__ void stage_rc(int b, int& R, int& C) { const int st = b / 1024, sb = b % 1024, swz = sb ^ (((sb >> 9) & 1) << 5); R = (st >> 1) * 16 + swz / 64; C = (st & 1) * 32 + (swz % 64) / 2; }
__host__ __device__ __forceinline__ int perm32(int rho) { const int n = rho >> 4, i = rho & 15; return 8 * (i >> 2) + 4 * n + (i & 3); }

struct Unit { int pm, pn, ko, sub; };
struct Gemm { const bf16_t* A; const bf16_t* Bt; int lda, ldb, nt; int kstepA, tileA;
};

struct StaticOrder {
    int nM, nN, nwg, G, c, nsub, ksub, pmfix, wgm, seg4;
    __device__ void init(int nM_, int nN_, int G_, int c_, int nsub_ = 1, int ksub_ = 0, int wgm_ = WGM) { nM = nM_; nN = nN_; nwg = nM * nN; G = G_; c = c_; nsub = nsub_; ksub = ksub_; pmfix = -1; wgm = wgm_; seg4 = 0; }
    __device__ void init_splitk(int nsplit, int nN_, int G_, int c_, int ksub_, int pmfix_) { nM = nsplit; nN = nN_; nwg = nM * nN; G = G_; c = c_; nsub = 1; ksub = ksub_; pmfix = pmfix_; wgm = WGM; seg4 = 0; }
    __device__ void init_seg4(int npan, int nN_, int G_, int c_, int ksub_, int pmfix_) { init_splitk(4 * npan, nN_, G_, c_, ksub_, pmfix_); seg4 = 1; }
    __device__ bool next(int i, Unit& u) const {
        const int ti = i / nsub, sub = i - ti * nsub;
        const long L = (long)ti * G + c; if (L >= nwg) return false;
        int wgid = (int)L; { const int q = nwg / NXCD, r = nwg % NXCD, xcd = wgid % NXCD, off = wgid / NXCD; wgid = (xcd < r ? xcd * (q + 1) : r * (q + 1) + (xcd - r) * q) + off; }
        const int nig = wgm * nN, gid = wgid / nig, fm = gid * wgm, gsz = (nM - fm) < wgm ? (nM - fm) : wgm;
        u.pm = fm + ((wgid % nig) % gsz); u.pn = (wgid % nig) / gsz; u.ko = sub * ksub; u.sub = sub;
        if (pmfix >= 0) { u.sub = u.pm; if (seg4) { u.ko = (u.pm & 3) * ksub; u.pm = pmfix + (u.pm >> 2); } else { u.ko = u.pm * ksub; u.pm = pmfix; } }
        return true;
    }
};

template <class Epi, class Sched, bool ALIGN_EPI>
__device__ __forceinline__ void gemm_phase(PG8_LAS unsigned char* lds, const int tid, const Gemm g, const Sched& S, const Epi& E) {
    const int wid = __builtin_amdgcn_readfirstlane(tid >> 6), lane = tid & 63, wr = wid >> 2, wc = wid & 3, fr = lane & 15, fq = lane >> 4;
    const int nt = g.nt;
    unsigned voffA, voffB;
    { int R, C; stage_rc(tid * 16, R, C); const int Rb = Epi::PERM ? ((R & ~31) + perm32(R & 31)) : R;
      voffA = (unsigned)(R * g.lda + C) * 2u; voffB = (unsigned)tid * 16u; (void)Rb; }
    const unsigned piece_voffA = 64u * (unsigned)g.lda * 2u, piece_voffB = 8192u;
    const unsigned kstep = 32768u, kstepA = (unsigned)g.kstepA;
    const unsigned hstepA = (unsigned)HALF * (unsigned)g.lda * 2u, hstepB = 16384u, tileB = (unsigned)(g.ldb >> 6) * 32768u;
    const unsigned ldsw = (unsigned)wid * 1024u;
    const int aoff = lds_byte(wr * 64 + fr, fq * 8), boff = lds_byte(wc * 32 + fr, fq * 8);
    const char* const baseA = (const char*)g.A; const char* const baseB = (const char*)g.Bt;
#define PG8_SA(b, h) (((b) * 2 + (h)) * HTB)
#define PG8_SB(b, h) ((4 + (b) * 2 + (h)) * HTB)
#define PG8_STAGE_(bufoff, gbase, goff, voff, piece) do { _Pragma("unroll") for (int _i = 0; _i < 2; ++_i) \
        __builtin_amdgcn_global_load_lds((const unsigned*)((gbase) + (size_t)(unsigned)((goff) + (_i ? (piece) : 0u) + (voff))), (PG8_LAS unsigned*)(lds + (bufoff) + ldsw + _i * 8192), 16, 0, 0); } while (0)
#define PG8_STAGE(bufoff, goff, voff) PG8_STAGE_(bufoff, base_##voff, goff, voff, piece_##voff)
#define base_voffA baseA
#define base_voffB baseB
#define PG8_LDA(dst, b, h) do { _Pragma("unroll") for (int m = 0; m < 4; ++m) _Pragma("unroll") for (int k = 0; k < 2; ++k) dst[m][k] = *(const PG8_LAS bf16x8*)(lds + PG8_SA(b, h) + aoff + m * 2048 + k * 1024); } while (0)
#define PG8_LDB(dst, b, h) do { _Pragma("unroll") for (int n = 0; n < 2; ++n) _Pragma("unroll") for (int k = 0; k < 2; ++k) dst[n][k] = *(const PG8_LAS bf16x8*)(lds + PG8_SB(b, h) + boff + n * 2048 + k * 1024); } while (0)
#define PG8_MMA(ai, bj, At, Bt) do { __builtin_amdgcn_s_setprio(1); _Pragma("unroll") for (int m = 0; m < 4; ++m) _Pragma("unroll") for (int n = 0; n < 2; ++n) _Pragma("unroll") for (int k = 0; k < 2; ++k) \
        acc[ai][bj][m][n] = __builtin_amdgcn_mfma_f32_16x16x32_bf16(Bt[n][k], At[m][k], acc[ai][bj][m][n], 0, 0, 0); __builtin_amdgcn_s_setprio(0); } while (0)
#define PG8_WAIT_V(n) asm volatile("s_waitcnt vmcnt(" #n ")" ::: "memory")
#define PG8_WAIT_L(n) asm volatile("s_waitcnt lgkmcnt(" #n ")" ::: "memory")
#define PG8_BAR __builtin_amdgcn_s_barrier()
#define PG8_SCHED __builtin_amdgcn_sched_barrier(0)
    Unit cur, nxt; int ui = 0;
    if (!S.next(0, cur)) return;
    f32x4 acc[2][2][4][2];
#pragma unroll
    for (int a = 0; a < 2; ++a)
#pragma unroll
        for (int b = 0; b < 2; ++b)
#pragma unroll
            for (int m = 0; m < 4; ++m)
#pragma unroll
                for (int n = 0; n < 2; ++n) acc[a][b][m][n] = (f32x4){0.f, 0.f, 0.f, 0.f};
    bf16x8 At[4][2], B0[2][2], B1[2][2];
    unsigned cA = (unsigned)cur.pm * (unsigned)g.tileA + (unsigned)(cur.ko >> 6) * kstepA, cB = (unsigned)cur.pn * tileB + (unsigned)(cur.ko >> 6) * kstep;
    PG8_STAGE(PG8_SB(0, 0), cB, voffB); PG8_STAGE(PG8_SB(0, 1), cB + hstepB, voffB); PG8_STAGE(PG8_SA(0, 0), cA, voffA); PG8_STAGE(PG8_SA(0, 1), cA + hstepA, voffA);
    if (wr == 1) PG8_BAR;
    PG8_WAIT_V(2); PG8_BAR;
    PG8_STAGE(PG8_SB(1, 0), cB + kstep, voffB); PG8_STAGE(PG8_SA(1, 0), cA + kstepA, voffA); PG8_STAGE(PG8_SB(1, 1), cB + hstepB + kstep, voffB);
    PG8_WAIT_V(6); PG8_BAR;
    for (;;) {
        const bool has_next = S.next(ui + 1, nxt);
        const unsigned nA = has_next ? (unsigned)nxt.pm * (unsigned)g.tileA + (unsigned)(nxt.ko >> 6) * kstepA : cA, nB = has_next ? (unsigned)nxt.pn * tileB + (unsigned)(nxt.ko >> 6) * kstep : cB;
        for (int t = 0; t < nt; t += 2) {
            const bool last = (t == nt - 2);
            const unsigned a1 = cA + (unsigned)(t + 1) * kstepA;
            const unsigned a2 = last ? nA : cA + (unsigned)(t + 2) * kstepA, b2 = last ? nB : cB + (unsigned)(t + 2) * kstep;
            const unsigned a3 = a2 + kstepA, b3 = b2 + kstep;
            PG8_LDB(B0, 0, 0); PG8_LDB(B1, 0, 1); PG8_SCHED; PG8_LDA(At, 0, 0); PG8_STAGE(PG8_SA(1, 1), a1 + hstepA, voffA);
            PG8_WAIT_V(8); PG8_WAIT_L(0); PG8_BAR; PG8_MMA(0, 0, At, B0); PG8_MMA(0, 1, At, B1); PG8_BAR; PG8_SCHED;
            PG8_LDA(At, 0, 1); PG8_STAGE(PG8_SB(0, 0), b2, voffB); PG8_STAGE(PG8_SB(0, 1), b2 + hstepB, voffB); PG8_STAGE(PG8_SA(0, 0), a2, voffA);
            PG8_WAIT_V(8); PG8_WAIT_L(0); PG8_BAR; PG8_MMA(1, 0, At, B0); PG8_MMA(1, 1, At, B1); PG8_BAR; PG8_SCHED;
            PG8_LDB(B0, 1, 0); PG8_LDB(B1, 1, 1); PG8_SCHED; PG8_LDA(At, 1, 0); PG8_STAGE(PG8_SA(0, 1), a2 + hstepA, voffA);
            PG8_WAIT_V(8); PG8_WAIT_L(0); PG8_BAR; PG8_MMA(0, 0, At, B0); PG8_MMA(0, 1, At, B1); PG8_BAR; PG8_SCHED;
            PG8_LDA(At, 1, 1); PG8_STAGE(PG8_SB(1, 0), b3, voffB); PG8_STAGE(PG8_SB(1, 1), b3 + hstepB, voffB); PG8_STAGE(PG8_SA(1, 0), a3, voffA);
            PG8_WAIT_V(8); PG8_WAIT_L(0); PG8_BAR; PG8_MMA(1, 0, At, B0); PG8_MMA(1, 1, At, B1); PG8_BAR; PG8_SCHED;
        }
        if constexpr (ALIGN_EPI) { if (wr == 0) PG8_BAR; }
        E(acc, cur, wr, wc, fr, fq);
        if (!has_next) break;
#pragma unroll
        for (int a = 0; a < 2; ++a)
#pragma unroll
            for (int b = 0; b < 2; ++b)
#pragma unroll
                for (int m = 0; m < 4; ++m)
#pragma unroll
                    for (int n = 0; n < 2; ++n) acc[a][b][m][n] = (f32x4){0.f, 0.f, 0.f, 0.f};
        cur = nxt; cA = nA; cB = nB; ++ui;
        if constexpr (ALIGN_EPI) { if (wr == 1) PG8_BAR; }
    }
    PG8_WAIT_V(0);
    if constexpr (!ALIGN_EPI) { if (wr == 0) PG8_BAR; }
    PG8_BAR;
#undef base_voffA
#undef base_voffB
#undef PG8_SA
#undef PG8_SB
#undef PG8_STAGE
#undef PG8_STAGE_
#undef PG8_LDA
#undef PG8_LDB
#undef PG8_MMA
#undef PG8_WAIT_V
#undef PG8_WAIT_L
#undef PG8_BAR
#undef PG8_SCHED
}

typedef f32x4 AccT[2][2][4][2];
struct EpiSwiglu {
    static constexpr bool PERM = true;
    bf16_t* G;
    __device__ __forceinline__ void operator()(const AccT& acc, const Unit& u, int wr, int wc, int fr, int fq) const {
        const int r0 = wr * 64 + fr, kt = u.pn * 2 + (wc >> 1), c0 = (wc & 1) * 32 + 8 * fq;
        bf16_t* blk = G + ((size_t)u.pm * (FF / 64) + kt) * (256 * 64) + c0;
#pragma unroll
        for (int ai = 0; ai < 2; ++ai)
#pragma unroll
            for (int m = 0; m < 4; ++m) {
                float v[8];
#pragma unroll
                for (int n = 0; n < 2; ++n)
#pragma unroll
                    for (int k = 0; k < 4; ++k) v[4 * n + k] = siluf_(acc[ai][0][m][n][k]) * acc[ai][1][m][n][k];
                *(u32x4*)(blk + (size_t)(r0 + ai * HALF + m * 16) * 64) = pack8(v);
            }
    }
};
struct EpiRes {
    static constexpr bool PERM = false;
    const float* resP; const float* resS; float* out; float s;
    __device__ __forceinline__ void operator()(const AccT& acc, const Unit& u, int wr, int wc, int fr, int fq) const {
        const int row0 = u.pm * BM + wr * 64 + fr, col0 = u.pn * BM + wc * 32 + 4 * fq;
        const float* res = (u.pm < 64) ? resP : resS;
#pragma unroll
        for (int ai = 0; ai < 2; ++ai) {
            f32x4 x[4][2][2];
#pragma unroll
            for (int m = 0; m < 4; ++m) { const size_t off = (size_t)(row0 + ai * HALF + m * 16) * D + col0;
#pragma unroll
                for (int bj = 0; bj < 2; ++bj)
#pragma unroll
                    for (int n = 0; n < 2; ++n) x[m][bj][n] = *(const f32x4*)(res + off + bj * HALF + n * 16); }
#pragma unroll
            for (int m = 0; m < 4; ++m) { const size_t off = (size_t)(row0 + ai * HALF + m * 16) * D + col0;
#pragma unroll
                for (int bj = 0; bj < 2; ++bj)
#pragma unroll
                    for (int n = 0; n < 2; ++n) *(f32x4*)(out + off + bj * HALF + n * 16) = x[m][bj][n] * ALPHA + acc[ai][bj][m][n] * s; }
            asm volatile("" ::: "memory"); }
    }
};
struct EpiSlab {
    static constexpr bool IDEM = true;
    static constexpr bool PERM = true;
    float* slab;
    __device__ __forceinline__ void operator()(const AccT& acc, const Unit& u, int wr, int wc, int fr, int fq) const {
        const int row0 = wr * 64 + fr, col0 = u.pn * BM + wc * 32 + 8 * fq;
        float* base = slab + (size_t)u.sub * 256 * D;
#pragma unroll
        for (int ai = 0; ai < 2; ++ai)
#pragma unroll
            for (int m = 0; m < 4; ++m) { const size_t off = (size_t)(row0 + ai * HALF + m * 16) * D + col0;
#pragma unroll
                for (int bj = 0; bj < 2; ++bj)
#pragma unroll
                    for (int n = 0; n < 2; ++n) *(f32x4*)(base + off + bj * HALF + n * 4) = acc[ai][bj][m][n]; }
    }
};
struct EpiY {
    static constexpr bool IDEM = true;
    static constexpr bool PERM = true;
    bf16_t* Y;
    __device__ __forceinline__ void operator()(const AccT& acc, const Unit& u, int wr, int wc, int fr, int fq) const {
        const int row0 = u.pm * BM + wr * 64 + fr, col0 = u.pn * BM + wc * 32 + 8 * fq;
#pragma unroll
        for (int ai = 0; ai < 2; ++ai)
#pragma unroll
            for (int m = 0; m < 4; ++m) { const int row = row0 + ai * HALF + m * 16;
#pragma unroll
                for (int bj = 0; bj < 2; ++bj) {
                    u32x4 w; w.x = pk2(acc[ai][bj][m][0][0], acc[ai][bj][m][0][1]); w.y = pk2(acc[ai][bj][m][0][2], acc[ai][bj][m][0][3]);
                    w.z = pk2(acc[ai][bj][m][1][0], acc[ai][bj][m][1][1]); w.w = pk2(acc[ai][bj][m][1][2], acc[ai][bj][m][1][3]);
                    *(u32x4*)(Y + (size_t)row * D + col0 + bj * HALF) = w; } }
    }
};
struct EpiInGate {
    static constexpr bool PERM = true;
    bf16_t* PROJ; bf16_t* GATE; const float* bgate; float* dkP; float* dvP; float* dkS; float* dvS;
    __device__ __forceinline__ void operator()(const AccT& acc, const Unit& u, int wr, int wc, int fr, int fq) const {
        const int row0 = u.pm * BM + wr * 64 + fr;
        if (u.pn < 22) {
            const int col0 = u.pn * BM + wc * 32 + 8 * fq;
            float* f32dst = nullptr; int fcol = 0;
            if (u.pn >= 16 && u.pn < 20) { const bool isk = u.pn < 18; fcol = col0 - (isk ? C_DK : C_DV);
                f32dst = (u.pm < 64) ? (isk ? dkP : dvP) : ((isk ? dkS : dvS) - (size_t)MP * 512); }
#pragma unroll
            for (int ai = 0; ai < 2; ++ai)
#pragma unroll
                for (int m = 0; m < 4; ++m) { const int row = row0 + ai * HALF + m * 16;
#pragma unroll
                    for (int bj = 0; bj < 2; ++bj) {
                        u32x4 w; w.x = pk2(acc[ai][bj][m][0][0], acc[ai][bj][m][0][1]); w.y = pk2(acc[ai][bj][m][0][2], acc[ai][bj][m][0][3]);
                        w.z = pk2(acc[ai][bj][m][1][0], acc[ai][bj][m][1][1]); w.w = pk2(acc[ai][bj][m][1][2], acc[ai][bj][m][1][3]);
                        *(u32x4*)(PROJ + (size_t)row * NIN + col0 + bj * HALF) = w;
                        if (f32dst) { float* p = f32dst + (size_t)row * 512 + fcol + bj * HALF; *(f32x4*)p = acc[ai][bj][m][0]; *(f32x4*)(p + 4) = acc[ai][bj][m][1]; }
                    } }
        } else {
            const int col0 = (u.pn - 22) * BM + wc * 32 + 8 * fq;
            const unsigned lane16 = (unsigned)(((wr * 4 + wc) * 4 + fq) * 16 + fr) * 16u;
            bf16_t* gtile = GATE + ((size_t)u.pm * 32 + (u.pn - 22)) * 65536;
            f32x4 bv[2][2];
#pragma unroll
            for (int bj = 0; bj < 2; ++bj)
#pragma unroll
                for (int n = 0; n < 2; ++n) bv[bj][n] = *(const f32x4*)(bgate + col0 + bj * HALF + 4 * n);
#pragma unroll
            for (int ai = 0; ai < 2; ++ai)
#pragma unroll
                for (int m = 0; m < 4; ++m) { const int row = row0 + ai * HALF + m * 16;
#pragma unroll
                    for (int bj = 0; bj < 2; ++bj) { float v[8];
#pragma unroll
                        for (int n = 0; n < 2; ++n)
#pragma unroll
                            for (int k = 0; k < 4; ++k) v[4 * n + k] = sigmoidf_(acc[ai][bj][m][n][k] + bv[bj][n][k]);
                        *(u32x4*)(((char*)gtile + ((ai * 4 + m) * 2 + bj) * 8192) + (size_t)lane16) = pack8(v); } }
        }
    }
};
struct EpiMemKV {
    static constexpr bool PERM = true;
    bf16_t* MKV; float* mk; float* mv;
    __device__ __forceinline__ void operator()(const AccT& acc, const Unit& u, int wr, int wc, int fr, int fq) const {
        const int row0 = u.pm * BM + wr * 64 + fr, col0 = u.pn * BM + wc * 32 + 8 * fq;
        float* dst = (u.pn < 2) ? mk : mv; const int fcol = col0 - (u.pn < 2 ? 0 : 512);
#pragma unroll
        for (int ai = 0; ai < 2; ++ai)
#pragma unroll
            for (int m = 0; m < 4; ++m) { const int row = row0 + ai * HALF + m * 16;
#pragma unroll
                for (int bj = 0; bj < 2; ++bj) {
                    u32x4 w; w.x = pk2(acc[ai][bj][m][0][0], acc[ai][bj][m][0][1]); w.y = pk2(acc[ai][bj][m][0][2], acc[ai][bj][m][0][3]);
                    w.z = pk2(acc[ai][bj][m][1][0], acc[ai][bj][m][1][1]); w.w = pk2(acc[ai][bj][m][1][2], acc[ai][bj][m][1][3]);
                    *(u32x4*)(MKV + (size_t)row * 1024 + col0 + bj * HALF) = w;
                    float* p = dst + (size_t)row * 512 + fcol + bj * HALF; *(f32x4*)p = acc[ai][bj][m][0]; *(f32x4*)(p + 4) = acc[ai][bj][m][1];
                } }
    }
};
struct EpiBranch {
    static constexpr bool IDEM = false;
    static constexpr bool PERM = true;
    bf16_t* GATE; bf16_t* MERGED;
    __device__ __forceinline__ void operator()(const AccT& acc, const Unit& u, int wr, int wc, int fr, int fq) const {
        const int row0 = u.pm * BM + wr * 64 + fr, col0 = u.pn * BM + wc * 32 + 8 * fq;
        const unsigned lane16 = (unsigned)(((wr * 4 + wc) * 4 + fq) * 16 + fr) * 16u;
        const char* gtile = (const char*)(GATE + ((size_t)u.pm * 32 + u.sub * 8 + u.pn) * 65536);
        const char* otile = gtile - (size_t)8 * 65536 * 2;
        bf16_t* mrow = MERGED + (size_t)row0 * D + col0;
#pragma unroll
        for (int ai = 0; ai < 2; ++ai)
#pragma unroll
          for (int mh = 0; mh < 2; ++mh) {
            u32x4 gw[2][2], ow[2][2];
#pragma unroll
            for (int m2 = 0; m2 < 2; ++m2) { const int m = 2 * mh + m2;
#pragma unroll
                for (int bj = 0; bj < 2; ++bj) { gw[m2][bj] = *(const u32x4*)((gtile + ((ai * 4 + m) * 2 + bj) * 8192) + (size_t)lane16);
                    if (u.sub != 0) ow[m2][bj] = *(const u32x4*)((otile + ((ai * 4 + m) * 2 + bj) * 8192) + (size_t)lane16); } }
#pragma unroll
            for (int m2 = 0; m2 < 2; ++m2) { const int m = 2 * mh + m2;
#pragma unroll
                for (int bj = 0; bj < 2; ++bj) {
                    float gt[8], v[8];
                    unpack8(gw[m2][bj], gt);
#pragma unroll
                    for (int n = 0; n < 2; ++n)
#pragma unroll
                        for (int k = 0; k < 4; ++k) v[4 * n + k] = gt[4 * n + k] * acc[ai][bj][m][n][k];
                    if (u.sub != 0) { float old[8]; unpack8(ow[m2][bj], old);
#pragma unroll
                        for (int k = 0; k < 8; ++k) v[k] += old[k]; }
                    if (u.sub == 3) *(u32x4*)(mrow + (size_t)(ai * HALF + m * 16) * D + bj * HALF) = pack8(v);
                    else *(u32x4*)(((char*)gtile + ((ai * 4 + m) * 2 + bj) * 8192) + (size_t)lane16) = pack8(v);
                } }
            asm volatile("" ::: "memory");
          }
    }
};
struct EpiBranchS {
    static constexpr bool IDEM = true;
    static constexpr bool PERM = true;
    const bf16_t* GATE; bf16_t* P;
    __device__ __forceinline__ void operator()(const AccT& acc, const Unit& u, int wr, int wc, int fr, int fq) const {
        const int r0 = wr * 64 + fr, col0 = u.pn * BM + wc * 32 + 8 * fq;
        const unsigned lane16 = (unsigned)(((wr * 4 + wc) * 4 + fq) * 16 + fr) * 16u;
        const char* gtile = (const char*)(GATE + ((size_t)u.pm * 32 + u.sub * 8 + u.pn) * 65536);
#pragma unroll
        for (int ai = 0; ai < 2; ++ai) {
            u32x4 gw[4][2];
#pragma unroll
            for (int m = 0; m < 4; ++m)
#pragma unroll
                for (int bj = 0; bj < 2; ++bj) gw[m][bj] = *(const u32x4*)((gtile + ((ai * 4 + m) * 2 + bj) * 8192) + (size_t)lane16);
#pragma unroll
            for (int m = 0; m < 4; ++m) { const int rp = r0 + ai * HALF + m * 16;
#pragma unroll
                for (int bj = 0; bj < 2; ++bj) {
                    float gt[8], v[8];
                    unpack8(gw[m][bj], gt);
#pragma unroll
                    for (int n = 0; n < 2; ++n)
#pragma unroll
                        for (int k = 0; k < 4; ++k) v[4 * n + k] = gt[4 * n + k] * acc[ai][bj][m][n][k];
                    *(u32x4*)(P + ((size_t)u.sub * 256 + rp) * D + col0 + bj * HALF) = pack8(v);
                } }
            asm volatile("" ::: "memory");
        }
    }
};
}

#define XB_TMO      128
#define XB_XCNT(j)  (256  + 64 * (j))
#define XB_XSUB(j)  (1280 + 64 * (j))
#define XB_XGEN(j)  (2304 + 64 * (j))
#define XB_TOP      3328
#define XB_TOPGEN   3392
#define XCD_BAR_WORDS 3456
#define XB_SPIN_CAP (1u << 18)
__device__ __forceinline__ unsigned xb_ld(unsigned* p)              { return __hip_atomic_load(p, __ATOMIC_RELAXED, __HIP_MEMORY_SCOPE_AGENT); }
__device__ __forceinline__ unsigned xb_add(unsigned* p, unsigned v) { return __hip_atomic_fetch_add(p, v, __ATOMIC_RELAXED, __HIP_MEMORY_SCOPE_AGENT); }
__device__ __forceinline__ unsigned xb_xcc_id() { return (unsigned)__builtin_amdgcn_s_getreg((3 << 11) | 20) & 0xFu; }
#define XB_SPIN(cond, bar) do { unsigned _sp = 0; while (cond) { __builtin_amdgcn_s_sleep(1); \
    if ((++_sp & 255u) == 0u) { if (xb_ld(&(bar)[XB_TMO])) break; if (_sp > XB_SPIN_CAP) { atomicAdd(&(bar)[XB_TMO], 1u); break; } } } } while (0)
struct XcdBarrier { unsigned* bar; unsigned x; volatile LAS unsigned* st; };
__device__ __forceinline__ XcdBarrier xcd_barrier_post(unsigned* bar, volatile LAS unsigned* st) {
    XcdBarrier b; b.bar = bar; b.x = xb_xcc_id(); b.st = st;
    if (threadIdx.x == 0) (void)xb_add(&bar[XB_XCNT(b.x)], 1u);
    return b;
}
__device__ __forceinline__ void xcd_barrier_complete(unsigned* bar, unsigned x, unsigned& nloc, unsigned& nx) {
    const unsigned G = gridDim.x * gridDim.y * gridDim.z;
    unsigned sum, cnt, mine, sp = 0u;
    for (;;) {
        sum = 0u; cnt = 0u; mine = 0u;
#pragma unroll
        for (unsigned j = 0; j < 16; ++j) { const unsigned c = xb_ld(&bar[XB_XCNT(j)]); sum += c; cnt += (c > 0u) ? 1u : 0u; mine = (j == x) ? c : mine; }
        if (sum == G) break;
        __builtin_amdgcn_s_sleep(1);
        if ((++sp & 255u) == 0u) { if (xb_ld(&bar[XB_TMO])) break; if (sp > XB_SPIN_CAP) { atomicAdd(&bar[XB_TMO], 1u); break; } }
    }
    nloc = mine > 0u ? mine : 1u; nx = cnt > 0u ? cnt : 1u;
}
__device__ __forceinline__ void xcd_barrier(const XcdBarrier& b) {
    asm volatile("s_waitcnt vmcnt(0)" ::: "memory");
    __syncthreads();
    if (threadIdx.x == 0) {
        unsigned* bar = b.bar;
        __builtin_amdgcn_s_waitcnt(0);
        unsigned nloc = b.st[0], nx = b.st[1];
        if (nloc == 0u) { xcd_barrier_complete(bar, b.x, nloc, nx); b.st[0] = nloc; b.st[1] = nx; }
        const unsigned old = xb_add(&bar[XB_XSUB(b.x)], 1u);
        const unsigned gen = old / nloc;
        if (old + 1u == (gen + 1u) * nloc) {
            __builtin_amdgcn_fence(__ATOMIC_RELEASE, "agent");
            asm volatile("s_waitcnt vmcnt(0)" ::: "memory");
            const unsigned og = xb_add(&bar[XB_TOP], 1u);
            const unsigned tg = og / nx;
            if (og + 1u == (tg + 1u) * nx) xb_add(&bar[XB_TOPGEN], 1u);
            else XB_SPIN(xb_ld(&bar[XB_TOPGEN]) == tg, bar);
            __builtin_amdgcn_fence(__ATOMIC_ACQUIRE, "agent");
            xb_add(&bar[XB_XGEN(b.x)], 1u);
            asm volatile("s_waitcnt vmcnt(0)" ::: "memory");
        } else {
            XB_SPIN(xb_ld(&bar[XB_XGEN(b.x)]) == gen, bar);
            __builtin_amdgcn_fence(__ATOMIC_ACQUIRE, "agent");
            asm volatile("s_waitcnt vmcnt(0)" ::: "memory");
        }
    }
    __syncthreads();
}

struct Args {
    const float* in[30]; float* out; unsigned char* ws; int ph_lo, ph_hi;
};
struct Frame {
    LAS unsigned char* lds; LAS unsigned char* aux; volatile LAS unsigned* MISC;
    gu32* ctl; int tid, lane, wave, G, bid;
    unsigned char* ws; float* out;
    float lam, omi;
};
constexpr int AUX_TBL = 4096;
DI const float* inp(const Frame& F, int k) {
    const LAS unsigned* t = (const LAS unsigned*)(F.aux + AUX_TBL) + 2 * k;
    const unsigned lo = (unsigned)__builtin_amdgcn_readfirstlane((int)t[0]), hi = (unsigned)__builtin_amdgcn_readfirstlane((int)t[1]);
    return (const float*)(const GAS float*)(((unsigned long long)hi << 32) | lo);
}
enum { I_XP = 0, I_XS, I_SCONV, I_SRET, I_CDK, I_CDV, I_CMK, I_CMV, I_MEMP, I_UP1, I_DN1, I_LN1G, I_LN1B, I_WIN, I_CONVW, I_RETG, I_DLAM, I_DSUB, I_WMKV, I_WBR, I_WGATE, I_BGATE, I_WO,
       I_LN2G, I_LN2B, I_UP2, I_DN2, I_LN3G, I_LN3B, I_RELB };

DI int wq_next(Frame& F, int k) {
    __syncthreads();
    if (F.tid == 0) F.MISC[0] = __hip_atomic_fetch_add((unsigned*)(F.ctl + CW_WQ + 64 * k), 1u, RLX_AGENT);
    __syncthreads();
    return __builtin_amdgcn_readfirstlane((int)F.MISC[0]);
}

DI void p0_transpose_item(const float* W, int N, int k0, int n0, bf16* WT, int ldk, int dst_row0, int kofs, LAS float* scr, int lane) {
    const int c4 = lane & 15, rr = lane >> 4;
#pragma unroll 4
    for (int i = 0; i < 16; ++i) { const int kk = 4 * i + rr; const f32x4 v = *(const f32x4*)(W + (size_t)(k0 + kk) * N + n0 + 4 * c4);
        LAS float* d = scr + kk * 65 + 4 * c4; d[0] = v.x; d[1] = v.y; d[2] = v.z; d[3] = v.w; }
    LDS_WAIT(); asm volatile("" ::: "memory");
    const int rs = lane & 15, ch = lane >> 4;
#pragma unroll
    for (int j = 0; j < 8; ++j) { const int sg = j >> 1, kh = j & 1;
        const int rho = 16 * (sg & 1) + rs, q = 32 * (sg >> 1) + pg8::perm32(rho);
        const LAS float* sp = scr + (32 * kh + 8 * ch) * 65 + q;
        u32x4 o; o.x = pk2(sp[0 * 65], sp[1 * 65]); o.y = pk2(sp[2 * 65], sp[3 * 65]); o.z = pk2(sp[4 * 65], sp[5 * 65]); o.w = pk2(sp[6 * 65], sp[7 * 65]);
        const int R0 = dst_row0, k = kofs + k0 + 32 * kh + 8 * ch;
        const int slot = (R0 & 64) + 32 * (sg >> 1) + rho;
        const size_t off = ((size_t)((R0 >> 8) * (ldk >> 6) + (k >> 6)) * 2 + ((R0 >> 7) & 1)) * 16384 + pg8::lds_byte(slot, k & 63);
        *(u32x4*)((char*)WT + off) = o; }
    LDS_WAIT(); asm volatile("" ::: "memory");
}
DI void p0_matrix(const float* W, int K, int N, int r, bf16* WT, int ldk, int mode, int row_base, int kofs, LAS float* scr, int lane) {
    const int nblk = N / 64, kb = r / nblk, nb = r - kb * nblk, n0 = 64 * nb;
    int drow = row_base + n0;
    if (mode == 1) { const int isb = n0 >= FF, nn = n0 - (isb ? FF : 0); drow = 256 * (nn >> 7) + (isb ? 128 : 0) + (nn & 127); }
    p0_transpose_item(W, N, 64 * kb, n0, WT, ldk, drow, kofs, scr, lane);
}
DI void p0_prologue(Frame& F, const Args& a, unsigned char* ws) {
    LAS float* scr = (LAS float*)(F.lds + F.wave * 16640);
    const int gw = F.bid * 8 + F.wave, NGW = F.G * 8;
    constexpr int I_UP = (D / 64) * (NUP / 64), I_DN = (FF / 64) * (D / 64), I_IN = (D / 64) * (NIN / 64), I_GT = 4 * (D / 64) * (D / 64), I_MK = (D / 64) * (1024 / 64),
                  I_BR = 4 * (512 / 64) * (D / 64), I_O = (D / 64) * (D / 64);
    constexpr int PER_LAYER = 2 * I_UP + 2 * I_DN + I_IN + I_GT + I_MK + I_BR + I_O;
    for (int it = gw; it < 2 * PER_LAYER; it += NGW) {
        const int l = it / PER_LAYER; int r = it - l * PER_LAYER;
        unsigned char* wl = ws + WS_W + (size_t)l * LAYER_W;
        if (r < I_UP) { p0_matrix(inp(F, I_UP1) + (size_t)l * D * NUP, D, NUP, r, (bf16*)(wl + W_UP1), D, 1, 0, 0, scr, F.lane); continue; } r -= I_UP;
        if (r < I_DN) { p0_matrix(inp(F, I_DN1) + (size_t)l * FF * D, FF, D, r, (bf16*)(wl + W_DN1), FF, 0, 0, 0, scr, F.lane); continue; } r -= I_DN;
        if (r < I_IN) { p0_matrix(inp(F, I_WIN) + (size_t)l * D * NIN, D, NIN, r, (bf16*)(wl + W_IG), D, 0, 0, 0, scr, F.lane); continue; } r -= I_IN;
        if (r < I_GT) { const int i = r / (I_GT / 4), rr = r - i * (I_GT / 4);
            p0_matrix(inp(F, I_WGATE) + ((size_t)l * 4 + i) * D * D, D, D, rr, (bf16*)(wl + W_IG), D, 0, NIN + i * D, 0, scr, F.lane); continue; } r -= I_GT;
        if (r < I_MK) { p0_matrix(inp(F, I_WMKV) + (size_t)l * D * 1024, D, 1024, r, (bf16*)(wl + W_MKV), D, 0, 0, 0, scr, F.lane); continue; } r -= I_MK;
        if (r < I_BR) { const int i = r / (I_BR / 4), rr = r - i * (I_BR / 4);
            p0_matrix(inp(F, I_WBR) + ((size_t)l * 4 + i) * 512 * D, 512, D, rr, (bf16*)(wl + W_BR), D, 0, 0, i * 512, scr, F.lane); continue; } r -= I_BR;
        if (r < I_O) { p0_matrix(inp(F, I_WO) + (size_t)l * D * D, D, D, r, (bf16*)(wl + W_WO), D, 0, 0, 0, scr, F.lane); continue; } r -= I_O;
        if (r < I_UP) { p0_matrix(inp(F, I_UP2) + (size_t)l * D * NUP, D, NUP, r, (bf16*)(wl + W_UP2), D, 1, 0, 0, scr, F.lane); continue; } r -= I_UP;
        p0_matrix(inp(F, I_DN2) + (size_t)l * FF * D, FF, D, r, (bf16*)(wl + W_DN2), FF, 0, 0, 0, scr, F.lane);
    }
    {
        const size_t gt = (size_t)F.bid * 512 + F.tid, NT = (size_t)F.G * 512;
        bf16* XB = (bf16*)(ws + WS_XB); bf16* MX = (bf16*)(ws + WS_MEMX);
        const size_t nP = (size_t)MP * D / 8, nS = (size_t)MS * D / 8, nM = (size_t)1024 * D / 8;
        for (size_t i = gt; i < nP + nS + nM; i += NT) {
            const float* src; bf16* dst;
            if (i < nP) { src = inp(F, I_XP) + i * 8; dst = XB + i * 8; }
            else if (i < nP + nS) { src = inp(F, I_XS) + (i - nP) * 8; dst = XB + i * 8; }
            else { src = inp(F, I_MEMP) + (i - nP - nS) * 8; dst = MX + (i - nP - nS) * 8; }
            const f32x4 v0 = *(const f32x4*)src, v1 = *(const f32x4*)(src + 4);
            u32x4 w; w.x = pk2(v0.x, v0.y); w.y = pk2(v0.z, v0.w); w.z = pk2(v1.x, v1.y); w.w = pk2(v1.z, v1.w);
            *(u32x4*)dst = w;
        }
        float* rc = (float*)(ws + WS_ROPE); float* rs = rc + 4096 * 64;
        for (size_t i = gt; i < (size_t)4096 * 64; i += NT) {
            const int pos = (int)(i >> 6), j = (int)(i & 63);
            const double invrev = exp2(-(double)j * (13.287712379549449 / 64.0)) * 0.15915494309189535;
            double rev = (double)pos * invrev; rev -= floor(rev);
            const float rf = (float)rev;
            rc[i] = __builtin_amdgcn_cosf(rf); rs[i] = __builtin_amdgcn_sinf(rf);
        }
    }
}

template <bool RESF32>
DI void ln_phase(Frame& F, const void* resP, const void* resS, const bf16* Y, float* outP, float* outS, bf16* XB, const float* g, const float* b, const float* slab, int nslab, float sscale) {
    const int gw = F.bid * 8 + F.wave, NGW = F.G * 8;
    f32x4 gv[8], bv[8];
#pragma unroll
    for (int j = 0; j < 8; ++j) { gv[j] = *(const f32x4*)(g + 4 * F.lane + 256 * j); bv[j] = *(const f32x4*)(b + 4 * F.lane + 256 * j); }
    for (int m = gw; m < M; m += NGW) {
        f32x4 v[8]; float s = 0.f;
        const bool samp = m >= MP;
        if (RESF32) { const f32x4* rr = (const f32x4*)((const float*)(samp ? resS : resP) + (size_t)(samp ? m - MP : m) * D) + F.lane;
#pragma unroll
            for (int j = 0; j < 8; ++j) v[j] = rr[64 * j] * ALPHA;
        } else { const u32x2* rr = (const u32x2*)((const bf16*)(samp ? resS : resP) + (size_t)(samp ? m - MP : m) * D) + F.lane;
#pragma unroll
            for (int j = 0; j < 8; ++j) { const u32x2 x = rr[64 * j]; v[j] = (f32x4){bf_lo(x.x), bf_hi(x.x), bf_lo(x.y), bf_hi(x.y)} * ALPHA; } }
        if (samp) {
            f32x4 acc[8];
#pragma unroll
            for (int j = 0; j < 8; ++j) acc[j] = (f32x4){0.f, 0.f, 0.f, 0.f};
#pragma unroll 4
            for (int k = 0; k < nslab; ++k) { const f32x4* sr = (const f32x4*)(slab + ((size_t)k * 256 + (m - MP)) * D) + F.lane;
#pragma unroll
                for (int j = 0; j < 8; ++j) acc[j] += sr[64 * j]; }
#pragma unroll
            for (int j = 0; j < 8; ++j) v[j] += acc[j] * sscale;
        } else {
            const u32x2* yr = (const u32x2*)(Y + (size_t)m * D) + F.lane;
#pragma unroll
            for (int j = 0; j < 8; ++j) { const u32x2 y = yr[64 * j]; v[j] += (f32x4){bf_lo(y.x), bf_hi(y.x), bf_lo(y.y), bf_hi(y.y)} * sscale; }
        }
#pragma unroll
        for (int j = 0; j < 8; ++j) s += (v[j].x + v[j].y) + (v[j].z + v[j].w);
        const float mean = wave_sum(s) * (1.f / D); float s2 = 0.f;
#pragma unroll
        for (int j = 0; j < 8; ++j) { v[j] = v[j] - mean; s2 += (v[j].x * v[j].x + v[j].y * v[j].y) + (v[j].z * v[j].z + v[j].w * v[j].w); }
        const float rstd = 1.f / sqrtf(wave_sum(s2) * (1.f / D) + LN_EPS);
        float* orow = outP ? (samp ? outS + (size_t)(m - MP) * D : outP + (size_t)m * D) : nullptr;
#pragma unroll
        for (int j = 0; j < 8; ++j) { const f32x4 o = v[j] * rstd * gv[j] + bv[j];
            if (orow) *((f32x4*)orow + F.lane + 64 * j) = o;
            if (XB) { u32x2 w; w.x = pk2(o.x, o.y); w.y = pk2(o.z, o.w); *((u32x2*)(XB + (size_t)m * D) + F.lane + 64 * j) = w; } }
    }
}

DI float gamma_log2(int h) { return h == 0 ? -0.045803689613124746f : h == 1 ? -0.022720076500083512f : h == 2 ? -0.011315313227834106f : -0.005646563141142085f; }
#define MFMA16(a, b, c) __builtin_amdgcn_mfma_f32_16x16x32_bf16((a), (b), (c), 0, 0, 0)
#define MFMA32(a, b, c) __builtin_amdgcn_mfma_f32_32x32x16_bf16((a), (b), (c), 0, 0, 0)

DI void rope8(const bf16* src  , int cp, const float* rc, const float* rs, int pos, float* o1, float* o2) {
    float x1[8], x2[8];
    unpack8(*(const u32x4*)(src + 8 * cp), x1); unpack8(*(const u32x4*)(src + 64 + 8 * cp), x2);
    const f32x4 c0 = *(const f32x4*)(rc + pos * 64 + 8 * cp), c1 = *(const f32x4*)(rc + pos * 64 + 8 * cp + 4);
    const f32x4 s0 = *(const f32x4*)(rs + pos * 64 + 8 * cp), s1 = *(const f32x4*)(rs + pos * 64 + 8 * cp + 4);
    const float cs[8] = {c0.x, c0.y, c0.z, c0.w, c1.x, c1.y, c1.z, c1.w}, sn[8] = {s0.x, s0.y, s0.z, s0.w, s1.x, s1.y, s1.z, s1.w};
#pragma unroll
    for (int j = 0; j < 8; ++j) { o1[j] = x1[j] * cs[j] - x2[j] * sn[j]; o2[j] = x2[j] * cs[j] + x1[j] * sn[j]; }
}
DI void lds_st16(LAS unsigned char* p, float v) { *(LAS unsigned short*)p = (unsigned short)(pk2(v, 0.f) & 0xffffu); }

DI void conv_task(Frame& F, const Args& a, int l, int task) {
    const bf16* PROJ = (const bf16*)(F.ws + WS_G); bf16* Y = (bf16*)(F.ws + WS_Y);
    const float* cw = inp(F, I_CONVW) + (size_t)l * 3 * 512;
    const int c0 = 8 * F.lane, r0 = task * 256 + F.wave * 32;
    float w0[8], w1[8], w2[8];
#pragma unroll
    for (int j = 0; j < 8; ++j) { w0[j] = cw[c0 + j]; w1[j] = cw[512 + c0 + j]; w2[j] = cw[1024 + c0 + j]; }
    float um1[8], um2[8];
#pragma unroll
    for (int j = 0; j < 8; ++j) { um1[j] = 0.f; um2[j] = 0.f; }
    for (int rr = -2; rr < 32; ++rr) {
        const int row = r0 + rr;
        const bool samp = row >= MP;
        const int tl = samp ? ((row - MP) & 15) : (row & 4095);
        if (rr < 0) { if (row < 0 || (r0 >= MP && row < MP)) continue; if ((samp ? ((r0 - MP) & 15) : (r0 & 4095)) + rr < 0) continue; }
        if (rr >= 0 && tl == 0) {
            if (!samp) {
#pragma unroll
                for (int j = 0; j < 8; ++j) { um1[j] = 0.f; um2[j] = 0.f; }
            } else { const float* sc = inp(F, I_SCONV) + (((size_t)l * 16 + ((row - MP) >> 4)) * 2) * 512 + c0;
#pragma unroll
                for (int j = 0; j < 8; ++j) { um2[j] = sc[j]; um1[j] = sc[512 + j]; } }
        }
        float cc[8], ch[8], u[8];
        unpack8(*(const u32x4*)(PROJ + (size_t)row * NIN + C_CC + c0), cc); unpack8(*(const u32x4*)(PROJ + (size_t)row * NIN + C_CH + c0), ch);
#pragma unroll
        for (int j = 0; j < 8; ++j) u[j] = cc[j] * ch[j];
        if (rr >= 0) {
            float cb[8], y[8]; unpack8(*(const u32x4*)(PROJ + (size_t)row * NIN + C_CB + c0), cb);
#pragma unroll
            for (int j = 0; j < 8; ++j) y[j] = cb[j] * (w0[j] * um2[j] + w1[j] * um1[j] + w2[j] * u[j]);
            *(u32x4*)(Y + (size_t)row * D + c0) = pack8(y);
            const int L = samp ? DSEQ : SEQ;
            if (tl >= L - 2) {
                float* dst = samp ? F.out + O_CONVS + (((size_t)l * 16 + ((row - MP) >> 4)) * 2 + (tl - (L - 2))) * 512 + c0
                                  : F.out + O_CONVP + (((size_t)l * 4 + (row >> 12)) * 2 + (tl - (L - 2))) * 512 + c0;
                *(f32x4*)dst = (f32x4){u[0], u[1], u[2], u[3]}; *(f32x4*)(dst + 4) = (f32x4){u[4], u[5], u[6], u[7]};
            }
        }
#pragma unroll
        for (int j = 0; j < 8; ++j) { um2[j] = um1[j]; um1[j] = u[j]; }
    }
}

constexpr int R1_KT = 0, R1_VT = 18432;
DI void ret1_task(Frame& F, const Args& a, int l, int unit) {
    const bf16* PROJ = (const bf16*)(F.ws + WS_G); float* RETKV = (float*)(F.ws + WS_XA);
    const float* rc = (const float*)(F.ws + WS_ROPE); const float* rs = rc + 4096 * 64;
    const int bh = unit >> 6, c = unit & 63, b = bh >> 2, h = bh & 3;
    const int row0 = b * SEQ + c * 64;
    const float lg = gamma_log2(h);
    {
        const int tok = F.tid >> 3, cp = F.tid & 7;
        float o1[8], o2[8];
        rope8(PROJ + (size_t)(row0 + tok) * NIN + C_RK + h * 128, cp, rc, rs, c * 64 + tok, o1, o2);
        const float sc = 0.08838834764831845f * fexp2(lg * (float)(63 - tok));
#pragma unroll
        for (int j = 0; j < 8; ++j) { lds_st16(F.lds + R1_KT + (8 * cp + j) * 144 + tok * 2, o1[j] * sc); lds_st16(F.lds + R1_KT + (64 + 8 * cp + j) * 144 + tok * 2, o2[j] * sc); }
#pragma unroll
        for (int i = 0; i < 2; ++i) { const int id = F.tid + 512 * i, tk = id >> 4, chn = id & 15;
            const u32x4 v = *(const u32x4*)(PROJ + (size_t)(row0 + tk) * NIN + C_RV + h * 128 + 8 * chn);
            const unsigned w[4] = {v.x, v.y, v.z, v.w};
#pragma unroll
            for (int j = 0; j < 4; ++j) { *(LAS unsigned short*)(F.lds + R1_VT + (8 * chn + 2 * j) * 144 + tk * 2) = (unsigned short)(w[j] & 0xffffu);
                                          *(LAS unsigned short*)(F.lds + R1_VT + (8 * chn + 2 * j + 1) * 144 + tk * 2) = (unsigned short)(w[j] >> 16); } }
    }
    __syncthreads();
    const int r16 = F.lane & 15, g = F.lane >> 4, w = F.wave;
    bf16x8 af[2];
#pragma unroll
    for (int ks = 0; ks < 2; ++ks) af[ks] = *(const LAS bf16x8*)(F.lds + R1_VT + (16 * w + r16) * 144 + (32 * ks + 8 * g) * 2);
    float* dst = RETKV + (size_t)unit * 16384;
#pragma unroll
    for (int dt = 0; dt < 8; ++dt) {
        f32x4 acc = {0.f, 0.f, 0.f, 0.f};
#pragma unroll
        for (int ks = 0; ks < 2; ++ks) { const bf16x8 bfr = *(const LAS bf16x8*)(F.lds + R1_KT + (16 * dt + r16) * 144 + (32 * ks + 8 * g) * 2); acc = MFMA16(af[ks], bfr, acc); }
#pragma unroll
        for (int r = 0; r < 4; ++r) dst[(16 * w + 4 * g + r) * 128 + 16 * dt + r16] = acc[r];
    }
}

DI void ret2_task(Frame& F, const Args& a, int l, int task) {
    const float* RETKV = (const float*)(F.ws + WS_XA); bf16* RETS = (bf16*)(F.ws + WS_RETS);
    const int bh = task >> 4, eb = task & 15, h = bh & 3;
    const int e = eb * 8 + (F.tid >> 6), d = 2 * (F.tid & 63);
    const float cdec = fexp2(gamma_log2(h) * 64.f);
    float s0 = 0.f, s1 = 0.f;
    const size_t base = ((size_t)bh * 64) * 16384 + e * 128 + d;
#pragma unroll 8
    for (int c = 0; c < 64; ++c) {
        const f32x2 v = *(const f32x2*)(RETKV + base + (size_t)c * 16384);
        *(unsigned*)(RETS + base + (size_t)c * 16384) = pk2(s0, s1);
        s0 = s0 * cdec + v.x; s1 = s1 * cdec + v.y;
    }
    float* o = F.out + O_RETP + ((size_t)l * 16 + bh) * 16384;
    o[d * 128 + e] = s0; o[(d + 1) * 128 + e] = s1;
}

constexpr int R3_Q = 0, R3_K = 17408, R3_VT = 34816, R3_ST = 53248, R3_ATT = 88064, R3_OF = 97280;
DI void ret_norm_store(Frame& F, const Args& a, int l, int h, int rowbase, int nrows, int of_off) {
    const bf16* PROJ = (const bf16*)(F.ws + WS_G); bf16* Y = (bf16*)(F.ws + WS_Y);
    const int i = F.tid >> 3, part = F.tid & 7;
    if (i < nrows) {
        const LAS float* of = (const LAS float*)(F.lds + of_off) + i * 132 + 16 * part;
        float x[16]; float s = 0.f;
#pragma unroll
        for (int k = 0; k < 16; ++k) { x[k] = of[k]; s += x[k]; }
        s += __shfl_xor(s, 1); s += __shfl_xor(s, 2); s += __shfl_xor(s, 4);
        const float mu = s * (1.f / 128.f); float q = 0.f;
#pragma unroll
        for (int k = 0; k < 16; ++k) { x[k] -= mu; q += x[k] * x[k]; }
        q += __shfl_xor(q, 1); q += __shfl_xor(q, 2); q += __shfl_xor(q, 4);
        const float rstd = 1.f / sqrtf(q * (1.f / 128.f) + LN_EPS);
        const float* gg = inp(F, I_RETG) + (size_t)l * 512 + h * 128 + 16 * part;
        const size_t row = (size_t)rowbase + i;
        float rg[16]; unpack8(*(const u32x4*)(PROJ + row * NIN + C_RG + h * 128 + 16 * part), rg); unpack8(*(const u32x4*)(PROJ + row * NIN + C_RG + h * 128 + 16 * part + 8), rg + 8);
        float y[16];
#pragma unroll
        for (int k = 0; k < 16; ++k) y[k] = siluf_(rg[k]) * (x[k] * rstd * gg[k]);
        *(u32x4*)(Y + row * D + 512 + h * 128 + 16 * part) = pack8(y); *(u32x4*)(Y + row * D + 512 + h * 128 + 16 * part + 8) = pack8(y + 8);
    }
}
DI void ret3_task(Frame& F, const Args& a, int l, int unit) {
    const bf16* PROJ = (const bf16*)(F.ws + WS_G); const bf16* RETS = (const bf16*)(F.ws + WS_RETS);
    const float* rc = (const float*)(F.ws + WS_ROPE); const float* rs = rc + 4096 * 64;
    const int bh = unit >> 6, c = unit & 63, b = bh >> 2, h = bh & 3;
    const int row0 = b * SEQ + c * 64;
    const float lg = gamma_log2(h);
    {
        const int tok = F.tid >> 3, cp = F.tid & 7;
        float o1[8], o2[8];
        rope8(PROJ + (size_t)(row0 + tok) * NIN + C_RQ + h * 128, cp, rc, rs, c * 64 + tok, o1, o2);
        *(LAS u32x4*)(F.lds + R3_Q + tok * 272 + 16 * cp) = pack8(o1); *(LAS u32x4*)(F.lds + R3_Q + tok * 272 + 128 + 16 * cp) = pack8(o2);
        rope8(PROJ + (size_t)(row0 + tok) * NIN + C_RK + h * 128, cp, rc, rs, c * 64 + tok, o1, o2);
#pragma unroll
        for (int j = 0; j < 8; ++j) { o1[j] *= 0.08838834764831845f; o2[j] *= 0.08838834764831845f; }
        *(LAS u32x4*)(F.lds + R3_K + tok * 272 + 16 * cp) = pack8(o1); *(LAS u32x4*)(F.lds + R3_K + tok * 272 + 128 + 16 * cp) = pack8(o2);
#pragma unroll
        for (int i = 0; i < 2; ++i) { const int id = F.tid + 512 * i, tk = id >> 4, chn = id & 15;
            const u32x4 v = *(const u32x4*)(PROJ + (size_t)(row0 + tk) * NIN + C_RV + h * 128 + 8 * chn);
            const unsigned w[4] = {v.x, v.y, v.z, v.w};
#pragma unroll
            for (int j = 0; j < 4; ++j) { *(LAS unsigned short*)(F.lds + R3_VT + (8 * chn + 2 * j) * 144 + tk * 2) = (unsigned short)(w[j] & 0xffffu);
                                          *(LAS unsigned short*)(F.lds + R3_VT + (8 * chn + 2 * j + 1) * 144 + tk * 2) = (unsigned short)(w[j] >> 16); } }
#pragma unroll
        for (int i = 0; i < 4; ++i) { const int id = F.tid + 512 * i, e = id >> 4, chn = id & 15;
            *(LAS u32x4*)(F.lds + R3_ST + e * 272 + 16 * chn) = *(const u32x4*)(RETS + (size_t)unit * 16384 + e * 128 + 8 * chn); }
    }
    __syncthreads();
    const int r16 = F.lane & 15, g = F.lane >> 4, w = F.wave, rb = w & 3, hw = w >> 2;
    bf16x8 qf[4];
#pragma unroll
    for (int ks = 0; ks < 4; ++ks) qf[ks] = *(const LAS bf16x8*)(F.lds + R3_Q + (16 * rb + r16) * 272 + (32 * ks + 8 * g) * 2);
#pragma unroll
    for (int t = 0; t < 2; ++t) { const int cb = 2 * hw + t;
        f32x4 acc = {0.f, 0.f, 0.f, 0.f};
#pragma unroll
        for (int ks = 0; ks < 4; ++ks) { const bf16x8 kf = *(const LAS bf16x8*)(F.lds + R3_K + (16 * cb + r16) * 272 + (32 * ks + 8 * g) * 2); acc = MFMA16(qf[ks], kf, acc); }
        const int j = 16 * cb + r16;
#pragma unroll
        for (int r = 0; r < 4; ++r) { const int i = 16 * rb + 4 * g + r; const float v = (i >= j) ? acc[r] * fexp2(lg * (float)(i - j)) : 0.f;
            lds_st16(F.lds + R3_ATT + i * 144 + j * 2, v); }
    }
    f32x4 oa[4];
#pragma unroll
    for (int t = 0; t < 4; ++t) { const int et = 4 * hw + t; f32x4 acc = {0.f, 0.f, 0.f, 0.f};
#pragma unroll
        for (int ks = 0; ks < 4; ++ks) { const bf16x8 sf = *(const LAS bf16x8*)(F.lds + R3_ST + (16 * et + r16) * 272 + (32 * ks + 8 * g) * 2); acc = MFMA16(qf[ks], sf, acc); }
#pragma unroll
        for (int r = 0; r < 4; ++r) acc[r] *= fexp2(lg * (float)(16 * rb + 4 * g + r + 1));
        oa[t] = acc; }
    __syncthreads();
    bf16x8 af[2];
#pragma unroll
    for (int ks = 0; ks < 2; ++ks) af[ks] = *(const LAS bf16x8*)(F.lds + R3_ATT + (16 * rb + r16) * 144 + (32 * ks + 8 * g) * 2);
#pragma unroll
    for (int t = 0; t < 4; ++t) { const int et = 4 * hw + t;
#pragma unroll
        for (int ks = 0; ks < 2; ++ks) { const bf16x8 vf = *(const LAS bf16x8*)(F.lds + R3_VT + (16 * et + r16) * 144 + (32 * ks + 8 * g) * 2); oa[t] = MFMA16(af[ks], vf, oa[t]); }
#pragma unroll
        for (int r = 0; r < 4; ++r) *((LAS float*)(F.lds + R3_OF) + (16 * rb + 4 * g + r) * 132 + 16 * et + r16) = oa[t][r]; }
    __syncthreads();
    ret_norm_store(F, a, l, h, row0, 64, R3_OF);
}

constexpr int RS_S0 = 0, RS_Q = 65536, RS_K = 73728, RS_V = 81920, RS_ATT = 90112, RS_OF = 91136;
DI void rets_task(Frame& F, const Args& a, int l, int unit) {
    const bf16* PROJ = (const bf16*)(F.ws + WS_G);
    const float* rc = (const float*)(F.ws + WS_ROPE); const float* rs = rc + 4096 * 64;
    const int b = unit >> 2, h = unit & 3, row0 = MP + b * 16;
    const float lg = gamma_log2(h);
    const float* s0g = inp(F, I_SRET) + (((size_t)l * 16 + b) * 4 + h) * 16384;
    LAS float* S0 = (LAS float*)(F.lds + RS_S0); LAS float* Q = (LAS float*)(F.lds + RS_Q); LAS float* K = (LAS float*)(F.lds + RS_K); LAS float* V = (LAS float*)(F.lds + RS_V);
    LAS float* ATT = (LAS float*)(F.lds + RS_ATT); LAS float* OF = (LAS float*)(F.lds + RS_OF);
#pragma unroll
    for (int i = 0; i < 8; ++i) { const int id = F.tid + 512 * i; *(LAS f32x4*)(S0 + 4 * id) = *(const f32x4*)(s0g + 4 * id); }
    if (F.tid < 128) { const int tok = F.tid >> 3, cp = F.tid & 7; float o1[8], o2[8];
        rope8(PROJ + (size_t)(row0 + tok) * NIN + C_RQ + h * 128, cp, rc, rs, PAST + tok, o1, o2);
#pragma unroll
        for (int j = 0; j < 8; ++j) { Q[tok * 128 + 8 * cp + j] = o1[j]; Q[tok * 128 + 64 + 8 * cp + j] = o2[j]; }
        rope8(PROJ + (size_t)(row0 + tok) * NIN + C_RK + h * 128, cp, rc, rs, PAST + tok, o1, o2);
#pragma unroll
        for (int j = 0; j < 8; ++j) { K[tok * 128 + 8 * cp + j] = o1[j] * 0.08838834764831845f; K[tok * 128 + 64 + 8 * cp + j] = o2[j] * 0.08838834764831845f; } }
    { const int tok = F.tid >> 5, c4 = F.tid & 31; const u32x2 v = *(const u32x2*)(PROJ + (size_t)(row0 + tok) * NIN + C_RV + h * 128 + 4 * c4);
      V[tok * 128 + 4 * c4] = bf_lo(v.x); V[tok * 128 + 4 * c4 + 1] = bf_hi(v.x); V[tok * 128 + 4 * c4 + 2] = bf_lo(v.y); V[tok * 128 + 4 * c4 + 3] = bf_hi(v.y); }
    __syncthreads();
    if (F.tid < 256) { const int i = F.tid >> 4, j = F.tid & 15; float s = 0.f;
        for (int d = 0; d < 128; ++d) s += Q[i * 128 + d] * K[j * 128 + d];
        ATT[i * 16 + j] = (i >= j) ? s * fexp2(lg * (float)(i - j)) : 0.f; }
    __syncthreads();
    {
        const int e = F.tid & 127, i0 = 4 * (F.tid >> 7);
        float o[4] = {0.f, 0.f, 0.f, 0.f};
        for (int d = 0; d < 128; ++d) { const float s = S0[d * 128 + e];
#pragma unroll
            for (int k = 0; k < 4; ++k) o[k] += Q[(i0 + k) * 128 + d] * s; }
#pragma unroll
        for (int k = 0; k < 4; ++k) { o[k] *= fexp2(lg * (float)(i0 + k + 1));
            for (int j = 0; j <= i0 + k; ++j) o[k] += ATT[(i0 + k) * 16 + j] * V[j * 128 + e];
            OF[(i0 + k) * 132 + e] = o[k]; }
        float* so = F.out + O_RETS + (((size_t)l * 16 + b) * 4 + h) * 16384;
        const float g16 = fexp2(lg * 16.f);
        float vv[16];
#pragma unroll
        for (int j = 0; j < 16; ++j) vv[j] = V[j * 128 + e] * fexp2(lg * (float)(15 - j));
        for (int dd = 0; dd < 32; ++dd) { const int d = 32 * (F.tid >> 7) + dd; float s = S0[d * 128 + e] * g16;
#pragma unroll
            for (int j = 0; j < 16; ++j) s += K[j * 128 + d] * vv[j];
            so[d * 128 + e] = s; }
    }
    __syncthreads();
    ret_norm_store(F, a, l, h, row0, 16, RS_OF);
}

constexpr int AT_KT = 0, AT_VT = 34816, AT_OXW = 16896;
struct AttnCfg {
    int nqt, nmap, nsplit;
    int nq;
    const bf16* qbase; int ldq;
    int qcol0, qcol1;
    int kcol0, kcol1;
    float qscale;
    int nkeys;
    const float* kf; const float* vf; int ldf; int nf32;
    const bf16* kb; const bf16* vb; int ldb;
    const bf16* vt; int ldvt;
    int qpos0;
    int bias;
    int chunkmask;
};
DI void attn_stage(Frame& F, const AttnCfg& C, int st) {
#pragma unroll
    for (int i = 0; i < 4; ++i) {
        const int id = F.tid + 512 * i, row = id >> 4, ch = id & 15, key = st * 128 + row;
        u32x4 kw = {0u, 0u, 0u, 0u}, vw = {0u, 0u, 0u, 0u};
        if (key < C.nf32) {
            const float* kp = C.kf + (size_t)key * C.ldf + 8 * ch; const float* vp = C.vf + (size_t)key * C.ldf + 8 * ch;
            const f32x4 k0 = *(const f32x4*)kp, k1 = *(const f32x4*)(kp + 4), v0 = *(const f32x4*)vp, v1 = *(const f32x4*)(vp + 4);
            kw.x = pk2(k0.x, k0.y); kw.y = pk2(k0.z, k0.w); kw.z = pk2(k1.x, k1.y); kw.w = pk2(k1.z, k1.w);
            vw.x = pk2(v0.x, v0.y); vw.y = pk2(v0.z, v0.w); vw.z = pk2(v1.x, v1.y); vw.w = pk2(v1.z, v1.w);
        } else if (key < C.nkeys) {
            kw = *(const u32x4*)(C.kb + (size_t)(key - C.nf32) * C.ldb + 8 * ch); vw = *(const u32x4*)(C.vb + (size_t)(key - C.nf32) * C.ldb + 8 * ch);
        }
        *(LAS u32x4*)(F.lds + AT_KT + row * 272 + 16 * ch) = kw;
        const unsigned w[4] = {vw.x, vw.y, vw.z, vw.w};
#pragma unroll
        for (int j = 0; j < 4; ++j) { *(LAS unsigned short*)(F.lds + AT_VT + (8 * ch + 2 * j) * 264 + row * 2) = (unsigned short)(w[j] & 0xffffu);
                                      *(LAS unsigned short*)(F.lds + AT_VT + (8 * ch + 2 * j + 1) * 264 + row * 2) = (unsigned short)(w[j] >> 16); }
    }
}

constexpr int AT_BUF = 69632;
template <int KS, bool PF>
DI void attn_run(Frame& F, const AttnCfg& C) {
    const int w = F.wave, r = F.lane & 31, hh = F.lane >> 5;
    const int per_qt = C.nmap * C.nsplit, qt = w / per_qt, rem = w - qt * per_qt, split = rem / C.nmap, map = rem - split * C.nmap;
    const bool active = qt < C.nqt;
    const int kcolm = map ? C.kcol1 : C.kcol0;
    bf16x8 qf[KS];
    {
        const int qr = qt * 32 + (r < C.nq ? r : C.nq - 1);
        const bf16* qp = C.qbase + (size_t)(active ? qr : 0) * C.ldq + (map ? C.qcol1 : C.qcol0) + 8 * hh;
#pragma unroll
        for (int ks = 0; ks < KS; ++ks) { float v[8]; unpack8(*(const u32x4*)(qp + 16 * ks), v);
#pragma unroll
            for (int j = 0; j < 8; ++j) v[j] *= C.qscale;
            qf[ks] = __builtin_bit_cast(bf16x8, pack8(v)); }
    }
    f32x16 o[4];
#pragma unroll
    for (int et = 0; et < 4; ++et)
#pragma unroll
        for (int i = 0; i < 16; ++i) o[et][i] = 0.f;
    float m = 0.f, lsum = 0.f; bool first = true;
    const int qpos_t = C.qpos0 + 32 * qt;
    const int klim = C.chunkmask ? 64 * ((qpos_t >> 6) + 1) : C.nkeys;
    const int nst = (C.nkeys + 127) >> 7;
    const LAS float* TB = (const LAS float*)(F.aux + AUX_BIAS);
#define AT_DMA(st_, bo_) do { _Pragma("unroll") for (int j = 0; j < 5; ++j) { const int blk = w + 8 * j; if (blk < 34) { const int c = blk * 64 + F.lane, row = c / 17, cc = c - row * 17, cq = cc < 16 ? cc : 15; \
        __builtin_amdgcn_global_load_lds((const unsigned*)(C.kb + (size_t)((st_) * 128 + row) * C.ldb + 8 * cq), (LAS unsigned*)(F.lds + (bo_) + AT_KT + blk * 1024), 16, 0, 0); \
        __builtin_amdgcn_global_load_lds((const unsigned*)(C.vt + (size_t)row * C.ldvt + (st_) * 128 + 8 * cq), (LAS unsigned*)(F.lds + (bo_) + AT_KT + 34816 + blk * 1024), 16, 0, 0); } } } while (0)
    if (PF) { __syncthreads(); AT_DMA(0, 0); VM_WAIT(); __syncthreads(); }
    for (int st = 0; st < nst; ++st) {
        const int bo = PF ? (st & 1) * AT_BUF : 0;
        if (!PF) { __syncthreads(); attn_stage(F, C, st); __syncthreads(); }
        else if (st + 1 < nst) AT_DMA(st + 1, ((st + 1) & 1) * AT_BUF);
        if (active) {
#pragma unroll 1
        for (int sb = 0; sb < 4; ++sb) {
            if (C.nsplit > 1 && sb != split) continue;
            const int kg = st * 128 + sb * 32;
            if (kg >= klim) continue;
            const bool fastb = C.bias && (kg + 31 - qpos_t <= -128);
            const float s0 = (fastb ? TB[0] : 0.f) - m;
            bf16x8 kfr[KS];
#pragma unroll
            for (int ks = 0; ks < KS; ++ks) kfr[ks] = *(const LAS bf16x8*)(F.lds + bo + AT_KT + (sb * 32 + r) * 272 + (kcolm + 16 * ks + 8 * hh) * 2);
            f32x16 s;
#pragma unroll
            for (int i = 0; i < 16; ++i) s[i] = s0;
#pragma unroll
            for (int ks = 0; ks < KS; ++ks) s = MFMA32(kfr[ks], qf[ks], s);
            u32x2 vlo[2][2], vhi[2][2];
#pragma unroll
            for (int et = 0; et < 2; ++et)
#pragma unroll
                for (int s2 = 0; s2 < 2; ++s2) { const LAS unsigned char* vp = F.lds + bo + AT_VT + (32 * et + r) * (PF ? 272 : 264) + (sb * 32 + 16 * s2 + 4 * hh) * 2;
                    vlo[et][s2] = *(const LAS u32x2*)vp; vhi[et][s2] = *(const LAS u32x2*)(vp + 16); }
            if (C.bias && !fastb) {
#pragma unroll
                for (int i = 0; i < 16; ++i) { const int key = kg + (i & 3) + 8 * (i >> 2) + 4 * hh; int idx = key - (qpos_t + r) + 128; idx = idx < 0 ? 0 : (idx > 191 ? 191 : idx); s[i] += TB[idx]; }
            }
            if (kg + 32 > C.nkeys) {
#pragma unroll
                for (int i = 0; i < 16; ++i) { const int key = kg + (i & 3) + 8 * (i >> 2) + 4 * hh; if (key >= C.nkeys) s[i] = -1e30f; }
            }
            float mx = s[0];
#pragma unroll
            for (int i = 1; i < 16; ++i) mx = fmaxf(mx, s[i]);
            { auto rr = __builtin_amdgcn_permlane32_swap(__float_as_uint(mx), __float_as_uint(mx), false, false); mx = fmaxf(__uint_as_float(rr[0]), __uint_as_float(rr[1])); }
            if (first || __any(mx > 8.0f)) {
                const float dl = first ? mx : fmaxf(mx, 0.f), al = fexp2(-dl); m += dl; lsum *= al;
#pragma unroll
                for (int i = 0; i < 16; ++i) s[i] -= dl;
#pragma unroll
                for (int et = 0; et < 4; ++et)
#pragma unroll
                    for (int i = 0; i < 16; ++i) o[et][i] *= al;
                first = false; }
            float p[16]; float ps = 0.f;
#pragma unroll
            for (int i = 0; i < 16; ++i) { p[i] = fexp2(s[i]); ps += p[i]; }
            lsum += ps;
            bf16x8 pf[2];
            pf[0] = __builtin_bit_cast(bf16x8, pack8(p)); pf[1] = __builtin_bit_cast(bf16x8, pack8(p + 8));
            u32x2 wlo[2][2], whi[2][2];
#pragma unroll
            for (int et = 0; et < 2; ++et)
#pragma unroll
                for (int s2 = 0; s2 < 2; ++s2) { const LAS unsigned char* vp = F.lds + bo + AT_VT + (32 * (et + 2) + r) * (PF ? 272 : 264) + (sb * 32 + 16 * s2 + 4 * hh) * 2;
                    wlo[et][s2] = *(const LAS u32x2*)vp; whi[et][s2] = *(const LAS u32x2*)(vp + 16); }
#pragma unroll
            for (int et = 0; et < 2; ++et)
#pragma unroll
                for (int s2 = 0; s2 < 2; ++s2) {
                    const u32x4 vv = {vlo[et][s2].x, vlo[et][s2].y, vhi[et][s2].x, vhi[et][s2].y};
                    o[et] = MFMA32(__builtin_bit_cast(bf16x8, vv), pf[s2], o[et]);
                }
#pragma unroll
            for (int et = 0; et < 2; ++et)
#pragma unroll
                for (int s2 = 0; s2 < 2; ++s2) {
                    const u32x4 vv = {wlo[et][s2].x, wlo[et][s2].y, whi[et][s2].x, whi[et][s2].y};
                    o[et + 2] = MFMA32(__builtin_bit_cast(bf16x8, vv), pf[s2], o[et + 2]);
                }
        }
        }
        if (PF) { VM_WAIT(); __syncthreads(); }
    }
#undef AT_DMA
    if (!PF) __syncthreads();
    { auto rr = __builtin_amdgcn_permlane32_swap(__float_as_uint(lsum), __float_as_uint(lsum), false, false); lsum = __uint_as_float(rr[0]) + __uint_as_float(rr[1]); }
    LAS float* OX = (LAS float*)(F.lds + w * AT_OXW);
#pragma unroll
    for (int et = 0; et < 4; ++et)
#pragma unroll
        for (int i = 0; i < 16; ++i) OX[(32 * et + (i & 3) + 8 * (i >> 2) + 4 * hh) * 33 + r] = o[et][i];
    if (hh == 0) { LAS float* ML = (LAS float*)(F.aux + AUX_ML) + (w * 32 + r) * 2; ML[0] = m; ML[1] = lsum; }
    __syncthreads();
}
DI void attn_combine(Frame& F, const AttnCfg& C, int qt, int rq, int map, float& v0, float& v1) {
    const LAS float* MLb = (const LAS float*)(F.aux + AUX_ML);
    const int per_qt = C.nmap * C.nsplit;
    float mstar = -1e30f;
    for (int sp = 0; sp < C.nsplit; ++sp) { const int ww = qt * per_qt + sp * C.nmap + map; mstar = fmaxf(mstar, MLb[(ww * 32 + rq) * 2]); }
    float L = 0.f, a0 = 0.f, a1 = 0.f;
    for (int sp = 0; sp < C.nsplit; ++sp) { const int ww = qt * per_qt + sp * C.nmap + map; const float wgt = fexp2(MLb[(ww * 32 + rq) * 2] - mstar);
        L += wgt * MLb[(ww * 32 + rq) * 2 + 1];
        const LAS float* OX = (const LAS float*)(F.lds + ww * AT_OXW);
        a0 += wgt * OX[(2 * F.lane) * 33 + rq]; a1 += wgt * OX[(2 * F.lane + 1) * 33 + rq]; }
    const float inv = 1.f / L; v0 = a0 * inv; v1 = a1 * inv;
}

DI void fill_bias_table(Frame& F, const Args& a, int h) {
    if (F.tid < 192) { const int rel = F.tid - 128, n = rel < 0 ? -rel : rel;
        int bk = n < 8 ? n : (n < 12 ? 8 : n < 16 ? 9 : n < 23 ? 10 : n < 32 ? 11 : n < 46 ? 12 : n < 64 ? 13 : n < 91 ? 14 : 15);
        if (rel > 0) bk += 16;
        ((LAS float*)(F.aux + AUX_BIAS))[F.tid] = inp(F, I_RELB)[bk * 4 + h] * LOG2E; }
}
DI void diff_lambda(const Frame& F, int l, float& lam, float& one_minus_init) {
    const float* lp = inp(F, I_DLAM) + (size_t)l * 256; float s1 = 0.f, s2 = 0.f;
    for (int i = 0; i < 64; ++i) { s1 += lp[i] * lp[64 + i]; s2 += lp[128 + i] * lp[192 + i]; }
    const float li = (l == 0) ? 0.2f : 0.35550906758730926f;
    lam = expf(s1) - expf(s2) + li; one_minus_init = 1.f - li;
}
DI void diff_finish(Frame& F, const Args& a, const AttnCfg& C, int l, int h, size_t yrow0, int nq_total) {
    const float lam = F.lam, omi = F.omi;
    bf16* Y = (bf16*)(F.ws + WS_Y);
    const float g0 = inp(F, I_DSUB)[(size_t)l * 128 + 2 * F.lane], g1 = inp(F, I_DSUB)[(size_t)l * 128 + 2 * F.lane + 1];
    for (int q = F.wave; q < nq_total; q += 8) {
        const int qt = q >> 5, rq = q & 31;
        float a0, a1, b0, b1; attn_combine(F, C, qt, rq, 0, a0, a1); attn_combine(F, C, qt, rq, 1, b0, b1);
        const float x0 = a0 - lam * b0, x1 = a1 - lam * b1;
        const float ss = wave_sum(x0 * x0 + x1 * x1);
        const float rn = 1.f / sqrtf(ss * (1.f / 128.f) + LN_EPS) * omi;
        *(unsigned*)(Y + (yrow0 + q) * D + 1024 + h * 128 + 2 * F.lane) = pk2(x0 * rn * g0, x1 * rn * g1);
    }
}
DI void mem_finish(Frame& F, const Args& a, const AttnCfg& C, int h, size_t yrow0, int nq_total) {
    bf16* Y = (bf16*)(F.ws + WS_Y);
    for (int q = F.wave; q < nq_total; q += 8) {
        const int qt = q >> 5, rq = q & 31; float a0, a1; attn_combine(F, C, qt, rq, 0, a0, a1);
        *(unsigned*)(Y + (yrow0 + q) * D + 1536 + h * 128 + 2 * F.lane) = pk2(a0, a1);
    }
}


DI void vtrans_task(Frame& F, int task) {
    const bf16* PROJ = (const bf16*)(F.ws + WS_G); bf16* VT = (bf16*)(F.ws + WS_VT);
    const int bh = task >> 4, kb = task & 15, b = bh >> 2, h = bh & 3;
#pragma unroll
    for (int i = 0; i < 8; ++i) { const int id = F.tid + 512 * i, key = id >> 4, ch = id & 15;
        const u32x4 v = *(const u32x4*)(PROJ + (size_t)(b * SEQ + kb * 256 + key) * NIN + C_DV + h * 128 + 8 * ch);
        const unsigned w[4] = {v.x, v.y, v.z, v.w};
#pragma unroll
        for (int j = 0; j < 4; ++j) { *(LAS unsigned short*)(F.lds + (8 * ch + 2 * j) * 528 + key * 2) = (unsigned short)(w[j] & 0xffffu);
                                      *(LAS unsigned short*)(F.lds + (8 * ch + 2 * j + 1) * 528 + key * 2) = (unsigned short)(w[j] >> 16); } }
    __syncthreads();
#pragma unroll
    for (int i = 0; i < 8; ++i) { const int id = F.tid + 512 * i, e = id >> 5, c32 = id & 31;
        *(u32x4*)(VT + ((size_t)(bh * 128 + e)) * 4096 + kb * 256 + 8 * c32) = *(const LAS u32x4*)(F.lds + e * 528 + 16 * c32); }
}

DI void diffp_task(Frame& F, const Args& a, int l, int task) {
    const bf16* PROJ = (const bf16*)(F.ws + WS_G);
    const int qb = 31 - (task >> 4), bh = task & 15, b = bh >> 2, h = bh & 3;
    __syncthreads(); fill_bias_table(F, a, h);
    AttnCfg C; C.nqt = 4; C.nmap = 2; C.nsplit = 1; C.nq = 32;
    C.qbase = PROJ + (size_t)(b * SEQ + qb * 128) * NIN; C.ldq = NIN; C.qcol0 = C_DQ + h * 128; C.qcol1 = C_DQ + h * 128 + 64; C.kcol0 = 0; C.kcol1 = 64;
    C.qscale = 0.125f * LOG2E; C.nkeys = 128 * (qb + 1); C.kf = nullptr; C.vf = nullptr; C.ldf = 0; C.nf32 = 0;
    C.kb = PROJ + (size_t)(b * SEQ) * NIN + C_DK + h * 128; C.vb = PROJ + (size_t)(b * SEQ) * NIN + C_DV + h * 128; C.ldb = NIN;
    C.qpos0 = qb * 128; C.bias = 1; C.chunkmask = 1;
    C.vt = (const bf16*)(F.ws + WS_VT) + (size_t)(bh * 128) * 4096; C.ldvt = 4096;
    attn_run<4, true>(F, C);
    diff_finish(F, a, C, l, h, (size_t)b * SEQ + qb * 128, 128);
}
DI void diffs_task(Frame& F, const Args& a, int l, int task) {
    const bf16* PROJ = (const bf16*)(F.ws + WS_G);
    const int b = task >> 2, h = task & 3;
    __syncthreads(); fill_bias_table(F, a, h);
    AttnCfg C; C.nqt = 1; C.nmap = 2; C.nsplit = 4; C.nq = 16;
    C.qbase = PROJ + (size_t)(MP + b * 16) * NIN; C.ldq = NIN; C.qcol0 = C_DQ + h * 128; C.qcol1 = C_DQ + h * 128 + 64; C.kcol0 = 0; C.kcol1 = 64;
    C.qscale = 0.125f * LOG2E; C.nkeys = PAST + DSEQ;
    C.kf = inp(F, I_CDK) + (((size_t)l * 16 + b) * PAST * 4 + h) * 128; C.vf = inp(F, I_CDV) + (((size_t)l * 16 + b) * PAST * 4 + h) * 128; C.ldf = 512; C.nf32 = PAST;
    C.kb = PROJ + (size_t)(MP + b * 16) * NIN + C_DK + h * 128; C.vb = PROJ + (size_t)(MP + b * 16) * NIN + C_DV + h * 128; C.ldb = NIN;
    C.qpos0 = PAST; C.bias = 1; C.chunkmask = 0;
    C.vt = nullptr; C.ldvt = 0;
    attn_run<4, false>(F, C);
    diff_finish(F, a, C, l, h, (size_t)MP + b * 16, 16);
}
DI void memp_task(Frame& F, const Args& a, int l, int task) {
    const bf16* PROJ = (const bf16*)(F.ws + WS_G); const bf16* MKV = (const bf16*)(F.ws + WS_MEMKV);
    const int qb = task >> 4, bh = task & 15, b = bh >> 2, h = bh & 3;
    AttnCfg C; C.nqt = 8; C.nmap = 1; C.nsplit = 1; C.nq = 32;
    C.qbase = PROJ + (size_t)(b * SEQ + qb * 256) * NIN; C.ldq = NIN; C.qcol0 = C_MQ + h * 128; C.qcol1 = 0; C.kcol0 = 0; C.kcol1 = 0;
    C.qscale = 0.08838834764831845f * LOG2E; C.nkeys = 256; C.kf = nullptr; C.vf = nullptr; C.ldf = 0; C.nf32 = 0;
    C.kb = MKV + (size_t)(b * 256) * 1024 + h * 128; C.vb = MKV + (size_t)(b * 256) * 1024 + 512 + h * 128; C.ldb = 1024;
    C.qpos0 = 0; C.bias = 0; C.chunkmask = 0;
    C.vt = nullptr; C.ldvt = 0;
    attn_run<8, false>(F, C);
    mem_finish(F, a, C, h, (size_t)b * SEQ + qb * 256, 256);
}
DI void mems_task(Frame& F, const Args& a, int l, int task) {
    const bf16* PROJ = (const bf16*)(F.ws + WS_G);
    const int b = task >> 2, h = task & 3;
    AttnCfg C; C.nqt = 1; C.nmap = 1; C.nsplit = 4; C.nq = 16;
    C.qbase = PROJ + (size_t)(MP + b * 16) * NIN; C.ldq = NIN; C.qcol0 = C_MQ + h * 128; C.qcol1 = 0; C.kcol0 = 0; C.kcol1 = 0;
    C.qscale = 0.08838834764831845f * LOG2E; C.nkeys = 256;
    C.kf = inp(F, I_CMK) + (((size_t)l * 16 + b) * 256 * 4 + h) * 128; C.vf = inp(F, I_CMV) + (((size_t)l * 16 + b) * 256 * 4 + h) * 128; C.ldf = 512; C.nf32 = 256;
    C.kb = nullptr; C.vb = nullptr; C.ldb = 0; C.qpos0 = 0; C.bias = 0; C.chunkmask = 0;
    C.vt = nullptr; C.ldvt = 0;
    attn_run<8, false>(F, C);
    mem_finish(F, a, C, h, (size_t)MP + b * 16, 16);
}

#ifndef PROBE_REPS
#define PROBE_REPS {1,1,1,1,1,1,1,1,1,1,1,1,1,1}
#endif
constexpr int REPS[14] = PROBE_REPS;
#ifndef PROBE_SUBREP
#define PROBE_SUBREP {1,1,1}
#endif
constexpr int SUBREP[3] = PROBE_SUBREP;
#define FRESH() do { int t_ = threadIdx.x; asm volatile("" : "+v"(t_)); F.tid = t_; F.lane = t_ & 63; F.wave = __builtin_amdgcn_readfirstlane(t_ >> 6); { unsigned long long wsi_ = (unsigned long long)args.ws; asm volatile("" : "+s"(wsi_)); ws = (unsigned char*)(GAS unsigned char*)wsi_; } F.ws = ws; F.out = (float*)inp(F, 30); \
    XB = (bf16*)(ws + WS_XB); Gb = (bf16*)(ws + WS_G); GATE = (bf16*)(ws + WS_GATE); Yb = (bf16*)(ws + WS_Y); wl = ws + WS_W + (size_t)l * LAYER_W; } while (0)
#define SEAM() do { XcdBarrier b_ = bar; unsigned long long bi_ = (unsigned long long)b_.bar; asm volatile("" : "+s"(bi_)); b_.bar = (unsigned*)(GAS unsigned*)bi_; xcd_barrier(b_); } while (0)
#define PHASE_LOCALS unsigned char* ws; bf16* XB; bf16* Gb; bf16* GATE; bf16* Yb; unsigned char* wl; const int nMall = M / 256; (void)Yb; (void)nMall; (void)XB; (void)Gb; (void)GATE; (void)wl

DI void ffn_half(Frame& F, const Args& args, const XcdBarrier& bar, const int l, const int half) {
    PHASE_LOCALS;
    for (int rep = 0; rep < REPS[1]; ++rep) { if (rep) SEAM(); FRESH(); pg8::Gemm g{XB, (const bf16*)(wl + (half ? W_UP2 : W_UP1)), D, D, D / 64, 128, 256 * D * 2}; pg8::StaticOrder S; S.init(nMall, NUP / 256, F.G, F.bid);
        pg8::EpiSwiglu E{Gb}; pg8::gemm_phase<pg8::EpiSwiglu, pg8::StaticOrder, true>(F.lds, F.tid, g, S, E); }
    SEAM();
    { FRESH();
        { pg8::Gemm g{Gb, (const bf16*)(wl + (half ? W_DN2 : W_DN1)), 64, FF, FF / 64, 32768, (FF / 64) * 32768}; pg8::StaticOrder S; S.init(MP / 256, D / 256, F.G, F.bid, 1, 0, 4);
          pg8::EpiY E{GATE}; pg8::gemm_phase<pg8::EpiY, pg8::StaticOrder, true>(F.lds, F.tid, g, S, E); }
        { pg8::Gemm g{Gb, (const bf16*)(wl + (half ? W_DN2 : W_DN1)), 64, FF, 8, 32768, (FF / 64) * 32768}; pg8::StaticOrder S; S.init_splitk(11, D / 256, F.G, F.G - 1 - F.bid, 512, MP / 256);
          pg8::EpiSlab E{(float*)(ws + WS_SLAB)}; pg8::gemm_phase<pg8::EpiSlab, pg8::StaticOrder, true>(F.lds, F.tid, g, S, E); } }
    SEAM();
    { FRESH();
        const float* lg = inp(F, half ? I_LN3G : I_LN1G) + (size_t)l * D; const float* lb = inp(F, half ? I_LN3B : I_LN1B) + (size_t)l * D;
        const bool fin = (l == 1 && half == 1);
        if (l == 0 && half == 0) ln_phase<true>(F, inp(F, I_XP), inp(F, I_XS), GATE, nullptr, nullptr, XB, lg, lb, (const float*)(ws + WS_SLAB), 11, 0.5f);
        else ln_phase<false>(F, XB, XB + (size_t)MP * D, GATE, fin ? F.out + O_YP : nullptr, fin ? F.out + O_YS : nullptr, fin ? nullptr : XB, lg, lb, (const float*)(ws + WS_SLAB), 11, 0.5f); }
}
DI void mixer_block(Frame& F, const Args& args, const XcdBarrier& bar, const int l) {
    PHASE_LOCALS;
    for (int rep = 0; rep < REPS[4]; ++rep) { if (rep) SEAM(); FRESH();
        { pg8::Gemm g{XB, (const bf16*)(wl + W_IG), D, D, D / 64, 128, 256 * D * 2}; pg8::StaticOrder S; S.init(nMall, NIG / 256, F.G, F.bid);
          pg8::EpiInGate E{Gb, GATE, inp(F, I_BGATE) + (size_t)l * NGATE, F.out + O_DKP + (size_t)l * MP * 512, F.out + O_DVP + (size_t)l * MP * 512,
                           F.out + O_DKS + (size_t)l * MS * 512, F.out + O_DVS + (size_t)l * MS * 512};
          pg8::gemm_phase<pg8::EpiInGate, pg8::StaticOrder, true>(F.lds, F.tid, g, S, E); }
        { pg8::Gemm g{(const bf16*)(ws + WS_MEMX), (const bf16*)(wl + W_MKV), D, D, D / 64, 128, 256 * D * 2}; pg8::StaticOrder S; S.init(4, 4, F.G, F.G - 1 - F.bid);
          pg8::EpiMemKV E{(bf16*)(ws + WS_MEMKV), F.out + O_MKP + (size_t)l * 1024 * 512, F.out + O_MVP + (size_t)l * 1024 * 512};
          pg8::gemm_phase<pg8::EpiMemKV, pg8::StaticOrder, true>(F.lds, F.tid, g, S, E); }
    }
    SEAM();
    for (int rep = 0; rep < REPS[5]; ++rep) { if (rep) SEAM(); FRESH();
        { const int t = F.bid - (F.G - 64); if (t >= 0 && t < 64) { __syncthreads(); rets_task(F, args, l, t); } }
        { const int t = F.bid - (F.G - 128); if (t >= 0 && t < 64) { __syncthreads(); mems_task(F, args, l, t); } }
        for (int t = F.bid; t < 65; t += F.G) { __syncthreads(); conv_task(F, args, l, t); }
        for (int t = F.bid; t < 1024; t += F.G) { __syncthreads(); ret1_task(F, args, l, t); }
        for (int t = F.bid; t < 256; t += F.G) { __syncthreads(); memp_task(F, args, l, t); }
        for (int t = F.bid; t < 256; t += F.G) { __syncthreads(); vtrans_task(F, t); }
        __syncthreads();
    }
    SEAM();
    for (int rep = 0; rep < REPS[6]; ++rep) { if (rep) SEAM(); FRESH();
        const int q = l * 64 + rep * 16;
        diff_lambda(F, l, F.lam, F.omi);
        for (int sr = 0; sr < SUBREP[0]; ++sr) for (;;) { const int t = wq_next(F, q + 5 + 32 * sr); if (t >= 64) break; diffs_task(F, args, l, t); }
        for (int sr = 0; sr < SUBREP[1]; ++sr) for (;;) { const int t = wq_next(F, q + 6 + 32 * sr); if (t >= 512) break; diffp_task(F, args, l, t); }
        for (int sr = 0; sr < SUBREP[2]; ++sr) for (int t = F.bid; t < 256; t += F.G) { __syncthreads(); ret2_task(F, args, l, t); }
    }
    SEAM();
    for (int rep = 0; rep < REPS[7]; ++rep) { if (rep) SEAM(); FRESH();
        for (int t = F.bid; t < 1024; t += F.G) { __syncthreads(); ret3_task(F, args, l, t); }
        __syncthreads();
    }
    SEAM();
    { FRESH();
        { pg8::Gemm g{Yb, (const bf16*)(wl + W_BR), D, D, 8, 128, 256 * D * 2}; pg8::StaticOrder S; S.init(MP / 256, D / 256, F.G, F.bid, 4, 512);
          pg8::EpiBranch E{GATE, Gb}; pg8::gemm_phase<pg8::EpiBranch, pg8::StaticOrder, true>(F.lds, F.tid, g, S, E); }
        { pg8::Gemm g{Yb, (const bf16*)(wl + W_BR), D, D, 8, 128, 256 * D * 2}; pg8::StaticOrder S; S.init_splitk(4, D / 256, F.G, F.G - 1 - F.bid, 512, MP / 256);
          pg8::EpiBranchS E{GATE, (bf16*)(ws + WS_BRS)}; pg8::gemm_phase<pg8::EpiBranchS, pg8::StaticOrder, true>(F.lds, F.tid, g, S, E); } }
    SEAM();
    { FRESH();
        { pg8::Gemm g{Gb, (const bf16*)(wl + W_WO), D, D, D / 64, 128, 256 * D * 2}; pg8::StaticOrder S; S.init(MP / 256, D / 256, F.G, F.bid);
          pg8::EpiY E{GATE}; pg8::gemm_phase<pg8::EpiY, pg8::StaticOrder, true>(F.lds, F.tid, g, S, E); }
        { pg8::Gemm g{(const bf16*)(ws + WS_BRS), (const bf16*)(wl + W_WO), D, D, 8, 128, 256 * D * 2}; pg8::StaticOrder S; S.init_seg4(4, D / 256, F.G, F.G - 1 - F.bid, 512, 0);
          pg8::EpiSlab E{(float*)(ws + WS_SLAB)}; pg8::gemm_phase<pg8::EpiSlab, pg8::StaticOrder, true>(F.lds, F.tid, g, S, E); } }
    SEAM();
    { FRESH(); ln_phase<false>(F, XB, XB + (size_t)MP * D, GATE, nullptr, nullptr, XB, inp(F, I_LN2G) + (size_t)l * D, inp(F, I_LN2B) + (size_t)l * D, (const float*)(ws + WS_SLAB), 16, 1.0f); }
    SEAM();
}

__global__ void __launch_bounds__(512, 2) fwd_kernel(Args args) {
    extern __shared__ __attribute__((aligned(16))) unsigned char lds_raw[];
    Frame F;
    F.lds = (LAS unsigned char*)lds_raw; F.aux = F.lds + AUX_OFF; F.MISC = (volatile LAS unsigned*)(F.aux + AUX_MISC);
    F.tid = threadIdx.x; F.lane = F.tid & 63; F.wave = __builtin_amdgcn_readfirstlane(F.tid >> 6); F.G = gridDim.x; F.bid = blockIdx.x;
    F.ctl = (gu32*)(args.ws + WS_CTL);
    for (int u = F.tid; u < 64; u += 512) F.MISC[u] = 0u;
    if (F.tid == 0) { LAS unsigned long long* tb = (LAS unsigned long long*)(F.aux + AUX_TBL);
#pragma unroll
        for (int k = 0; k < 30; ++k) tb[k] = (unsigned long long)args.in[k];
        tb[30] = (unsigned long long)args.out; }
    __syncthreads();
    const XcdBarrier bar = xcd_barrier_post((unsigned*)(F.ctl + CW_BAR), F.MISC + 8);
    { PHASE_LOCALS; for (int rep = 0; rep < REPS[0]; ++rep) { if (rep) SEAM(); const int l = 0; FRESH(); p0_prologue(F, args, ws); } SEAM(); }
    ffn_half(F, args, bar, 0, 0); { SEAM(); }
    mixer_block(F, args, bar, 0);
    ffn_half(F, args, bar, 0, 1); { SEAM(); }
    ffn_half(F, args, bar, 1, 0); { SEAM(); }
    mixer_block(F, args, bar, 1);
    ffn_half(F, args, bar, 1, 1);
}
#undef SEAM
#undef FRESH

extern "C" void kernel_launch(void* const* d_in, const int* in_sizes, int n_in, void* d_out, int out_size, void* d_ws, size_t ws_size, hipStream_t stream) {
    static int grid = 0;
    if (grid == 0) {
        if (n_in != 30 || (size_t)out_size != O_END || ws_size < WS_END) { fprintf(stderr, "kernel_launch: unexpected sizes: n_in %d out %d (want %zu) ws %zu (want >= %zu)\n", n_in, out_size, (size_t)O_END, ws_size, (size_t)WS_END); grid = -1; return; }
        int dev = 0, cus = 0, per_cu = 0;
        if (hipGetDevice(&dev) != hipSuccess || hipDeviceGetAttribute(&cus, hipDeviceAttributeMultiprocessorCount, dev) != hipSuccess) { grid = -1; return; }
        if (hipFuncSetAttribute((const void*)fwd_kernel, hipFuncAttributeMaxDynamicSharedMemorySize, LDS_BYTES) != hipSuccess) { fprintf(stderr, "kernel_launch: hipFuncSetAttribute failed\n"); grid = -1; return; }
        if (hipOccupancyMaxActiveBlocksPerMultiprocessor(&per_cu, (const void*)fwd_kernel, 512, LDS_BYTES) != hipSuccess || per_cu < 1) fprintf(stderr, "kernel_launch: occupancy query says %d\n", per_cu);
        (void)hipGetLastError();
        grid = cus;
    }
    if (grid < 0) return;
    (void)hipMemsetAsync((char*)d_ws + WS_CTL, 0, CTL_ZERO_BYTES, stream);
    Args a{};
    for (int i = 0; i < 30; ++i) a.in[i] = (const float*)d_in[i];
    a.out = (float*)d_out; a.ws = (unsigned char*)d_ws;
    a.ph_lo = 0; a.ph_hi = 0;
    hipLaunchKernelGGL(fwd_kernel, dim3(grid), dim3(512), LDS_BYTES, stream, a);
}
```

```cpp
#include <hip/hip_runtime.h>
#include <cstdio>
#include <cstdint>

#define GAS __attribute__((address_space(1)))
#define LAS __attribute__((address_space(3)))
typedef unsigned short bf16;
typedef short bf16x8 __attribute__((ext_vector_type(8)));
typedef float f32x2 __attribute__((ext_vector_type(2)));
typedef float f32x4 __attribute__((ext_vector_type(4)));
typedef float f32x16 __attribute__((ext_vector_type(16)));
typedef unsigned u32x2 __attribute__((ext_vector_type(2)));
typedef unsigned u32x4 __attribute__((ext_vector_type(4)));
typedef __bf16 bf16v2 __attribute__((ext_vector_type(2)));
typedef GAS unsigned gu32;
#define DI __device__ __forceinline__
#define RLX_AGENT __ATOMIC_RELAXED, __HIP_MEMORY_SCOPE_AGENT

constexpr int D = 2048, FF = 5632, NUP = 2 * FF, NIN = 5632, NGATE = 8192, NIG = NIN + NGATE;
constexpr int MP = 16384, MS = 256, M = MP + MS;
constexpr int SEQ = 4096, PAST = 2048, DSEQ = 16;
constexpr int C_CB = 0, C_CC = 512, C_CH = 1024, C_RQ = 1536, C_RK = 2048, C_RV = 2560, C_RG = 3072, C_DQ = 3584, C_DK = 4096, C_DV = 4608, C_MQ = 5120;
constexpr float LN_EPS = 1e-5f;
constexpr float ALPHA = 1.4142135623730951f;
constexpr float LOG2E = 1.4426950408889634f;
constexpr size_t O_YP = 0, O_YS = O_YP + (size_t)MP * D, O_CONVP = O_YS + (size_t)MS * D, O_RETP = O_CONVP + 2 * 4 * 2 * 512,
                 O_DKP = O_RETP + 2 * 4 * 4 * 128 * 128, O_DVP = O_DKP + (size_t)2 * MP * 512, O_MKP = O_DVP + (size_t)2 * MP * 512,
                 O_MVP = O_MKP + 2 * 1024 * 512, O_CONVS = O_MVP + 2 * 1024 * 512, O_RETS = O_CONVS + 2 * 16 * 2 * 512,
                 O_DKS = O_RETS + 2 * 16 * 4 * 128 * 128, O_DVS = O_DKS + 2 * 256 * 512, O_END = O_DVS + 2 * 256 * 512;

constexpr size_t MiB = 1u << 20;
constexpr size_t WS_CTL = 0, CTL_ZERO_BYTES = 1 * MiB;
constexpr size_t WS_ROPE = 1 * MiB;
constexpr size_t WS_MEMX = 3 * MiB;
constexpr size_t WS_MEMKV = 7 * MiB;
constexpr size_t WS_W = 16 * MiB;
constexpr size_t W_UP1 = 0, W_DN1 = W_UP1 + (size_t)NUP * D * 2, W_IG = W_DN1 + (size_t)D * FF * 2, W_MKV = W_IG + (size_t)NIG * D * 2,
                 W_BR = W_MKV + (size_t)1024 * D * 2, W_WO = W_BR + (size_t)D * D * 2, W_UP2 = W_WO + (size_t)D * D * 2, W_DN2 = W_UP2 + (size_t)NUP * D * 2,
                 LAYER_W = W_DN2 + (size_t)D * FF * 2;
constexpr size_t WS_XA = WS_W + 2 * LAYER_W;
constexpr size_t WS_XB = WS_XA + (size_t)M * D * 4;
constexpr size_t WS_G = WS_XB + (size_t)M * D * 2;
constexpr size_t WS_GATE = WS_G + (size_t)M * FF * 2;
constexpr size_t WS_Y = WS_GATE + (size_t)M * NGATE * 2;
constexpr size_t WS_RETS = WS_Y + (size_t)M * D * 2;
constexpr size_t WS_SLAB = WS_RETS + (size_t)1024 * 128 * 128 * 2;
constexpr size_t WS_VT = WS_SLAB + (size_t)16 * 256 * D * 4;
constexpr size_t WS_BRS = WS_VT + (size_t)16 * 128 * 4096 * 2;
constexpr size_t WS_END = WS_BRS + (size_t)4 * 256 * D * 2;
static_assert(LAYER_W == (size_t)216006656, "layer weights");
static_assert((size_t)1024 * 128 * 128 * 4 <= (size_t)M * D * 4, "RETKV fits its region");
constexpr int CW_BAR = 4096;
constexpr int CW_WQ = 16384;

constexpr int LDS_SCRATCH = 139264;
constexpr int AUX_OFF = LDS_SCRATCH;
constexpr int AUX_ML = 0, AUX_BIAS = 2048, AUX_MISC = 3072;
constexpr int LDS_BYTES = 147456;

DI unsigned pk2(float lo, float hi) { f32x2 v = {lo, hi}; return __builtin_bit_cast(unsigned, __builtin_convertvector(v, bf16v2)); }
DI float bf_lo(unsigned u) { return __uint_as_float(u << 16); }
DI float bf_hi(unsigned u) { return __uint_as_float(u & 0xffff0000u); }
DI float bf2f(bf16 b) { return __uint_as_float(((unsigned)b) << 16); }
DI float fexp2(float x) { return __builtin_amdgcn_exp2f(x); }
DI float frcp(float x) { return __builtin_amdgcn_rcpf(x); }
DI float sigmoidf_(float x) { return frcp(1.0f + fexp2(-x * LOG2E)); }
DI float siluf_(float x) { return x * sigmoidf_(x); }
DI u32x4 pack8(const float* v) { u32x4 w; w.x = pk2(v[0], v[1]); w.y = pk2(v[2], v[3]); w.z = pk2(v[4], v[5]); w.w = pk2(v[6], v[7]); return w; }
DI void unpack8(u32x4 w, float* v) { v[0] = bf_lo(w.x); v[1] = bf_hi(w.x); v[2] = bf_lo(w.y); v[3] = bf_hi(w.y); v[4] = bf_lo(w.z); v[5] = bf_hi(w.z); v[6] = bf_lo(w.w); v[7] = bf_hi(w.w); }
DI float wave_sum(float v) {
#pragma unroll
    for (int o = 1; o < 64; o <<= 1) v += __shfl_xor(v, o);
    return v;
}
#define LDS_WAIT() asm volatile("s_waitcnt lgkmcnt(0)" ::: "memory")
#define VM_WAIT() asm volatile("s_waitcnt vmcnt(0)" ::: "memory")

namespace pg8 {
#define PG8_LAS __attribute__((address_space(3)))
typedef unsigned short bf16_t;
constexpr int BM = 256, BK = 64, HALF = 128, HTB = HALF * BK * 2, STAGE_BYTES = 8 * HTB, NXCD = 8, WGM = 8;
__host__ __device__ __forceinline__ int lds_byte(int r, int c) { const int st = (r >> 4) * 2 + (c >> 5), rr = r & 15, cc = c & 31, ob = rr * 64 + cc * 2; return st * 1024 + (ob ^ (((ob >> 9) & 1) << 5)); }
__host__ __device__ __forceinline__ void stage_rc(int b, int& R, int& C) { const int st = b / 1024, sb = b % 1024, swz = sb ^ (((sb >> 9) & 1) << 5); R = (st >> 1) * 16 + swz / 64; C = (st & 1) * 32 + (swz % 64) / 2; }
__host__ __device__ __forceinline__ int perm32(int rho) { const int n = rho >> 4, i = rho & 15; return 8 * (i >> 2) + 4 * n + (i & 3); }

struct Unit { int pm, pn, ko, sub; };
struct Gemm { const bf16_t* A; const bf16_t* Bt; int lda, ldb, nt; int kstepA, tileA;
};

struct StaticOrder {
    int nM, nN, nwg, G, c, nsub, ksub, pmfix, wgm, seg4;
    __device__ void init(int nM_, int nN_, int G_, int c_, int nsub_ = 1, int ksub_ = 0, int wgm_ = WGM) { nM = nM_; nN = nN_; nwg = nM * nN; G = G_; c = c_; nsub = nsub_; ksub = ksub_; pmfix = -1; wgm = wgm_; seg4 = 0; }
    __device__ void init_splitk(int nsplit, int nN_, int G_, int c_, int ksub_, int pmfix_) { nM = nsplit; nN = nN_; nwg = nM * nN; G = G_; c = c_; nsub = 1; ksub = ksub_; pmfix = pmfix_; wgm = WGM; seg4 = 0; }
    __device__ void init_seg4(int npan, int nN_, int G_, int c_, int ksub_, int pmfix_) { init_splitk(4 * npan, nN_, G_, c_, ksub_, pmfix_); seg4 = 1; }
    __device__ bool next(int i, Unit& u) const {
        const int ti = i / nsub, sub = i - ti * nsub;
        const long L = (long)ti * G + c; if (L >= nwg) return false;
        int wgid = (int)L; { const int q = nwg / NXCD, r = nwg % NXCD, xcd = wgid % NXCD, off = wgid / NXCD; wgid = (xcd < r ? xcd * (q + 1) : r * (q + 1) + (xcd - r) * q) + off; }
        const int nig = wgm * nN, gid = wgid / nig, fm = gid * wgm, gsz = (nM - fm) < wgm ? (nM - fm) : wgm;
        u.pm = fm + ((wgid % nig) % gsz); u.pn = (wgid % nig) / gsz; u.ko = sub * ksub; u.sub = sub;
        if (pmfix >= 0) { u.sub = u.pm; if (seg4) { u.ko = (u.pm & 3) * ksub; u.pm = pmfix + (u.pm >> 2); } else { u.ko = u.pm * ksub; u.pm = pmfix; } }
        return true;
    }
};

template <class Epi, class Sched, bool ALIGN_EPI>
__device__ __forceinline__ void gemm_phase(PG8_LAS unsigned char* lds, const int tid, const Gemm g, const Sched& S, const Epi& E) {
    const int wid = __builtin_amdgcn_readfirstlane(tid >> 6), lane = tid & 63, wr = wid >> 2, wc = wid & 3, fr = lane & 15, fq = lane >> 4;
    const int nt = g.nt;
    unsigned voffA, voffB;
    { int R, C; stage_rc(tid * 16, R, C); const int Rb = Epi::PERM ? ((R & ~31) + perm32(R & 31)) : R;
      voffA = (unsigned)(R * g.lda + C) * 2u; voffB = (unsigned)tid * 16u; (void)Rb; }
    const unsigned piece_voffA = 64u * (unsigned)g.lda * 2u, piece_voffB = 8192u;
    const unsigned kstep = 32768u, kstepA = (unsigned)g.kstepA;
    const unsigned hstepA = (unsigned)HALF * (unsigned)g.lda * 2u, hstepB = 16384u, tileB = (unsigned)(g.ldb >> 6) * 32768u;
    const unsigned ldsw = (unsigned)wid * 1024u;
    const int aoff = lds_byte(wr * 64 + fr, fq * 8), boff = lds_byte(wc * 32 + fr, fq * 8);
    const char* const baseA = (const char*)g.A; const char* const baseB = (const char*)g.Bt;
#define PG8_SA(b, h) (((b) * 2 + (h)) * HTB)
#define PG8_SB(b, h) ((4 + (b) * 2 + (h)) * HTB)
#define PG8_STAGE_(bufoff, gbase, goff, voff, piece) do { _Pragma("unroll") for (int _i = 0; _i < 2; ++_i) \
        __builtin_amdgcn_global_load_lds((const unsigned*)((gbase) + (size_t)(unsigned)((goff) + (_i ? (piece) : 0u) + (voff))), (PG8_LAS unsigned*)(lds + (bufoff) + ldsw + _i * 8192), 16, 0, 0); } while (0)
#define PG8_STAGE(bufoff, goff, voff) PG8_STAGE_(bufoff, base_##voff, goff, voff, piece_##voff)
#define base_voffA baseA
#define base_voffB baseB
#define PG8_LDA(dst, b, h) do { _Pragma("unroll") for (int m = 0; m < 4; ++m) _Pragma("unroll") for (int k = 0; k < 2; ++k) dst[m][k] = *(const PG8_LAS bf16x8*)(lds + PG8_SA(b, h) + aoff + m * 2048 + k * 1024); } while (0)
#define PG8_LDB(dst, b, h) do { _Pragma("unroll") for (int n = 0; n < 2; ++n) _Pragma("unroll") for (int k = 0; k < 2; ++k) dst[n][k] = *(const PG8_LAS bf16x8*)(lds + PG8_SB(b, h) + boff + n * 2048 + k * 1024); } while (0)
#define PG8_MMA(ai, bj, At, Bt) do { __builtin_amdgcn_s_setprio(1); _Pragma("unroll") for (int m = 0; m < 4; ++m) _Pragma("unroll") for (int n = 0; n < 2; ++n) _Pragma("unroll") for (int k = 0; k < 2; ++k) \
        acc[ai][bj][m][n] = __builtin_amdgcn_mfma_f32_16x16x32_bf16(Bt[n][k], At[m][k], acc[ai][bj][m][n], 0, 0, 0); __builtin_amdgcn_s_setprio(0); } while (0)
#define PG8_WAIT_V(n) asm volatile("s_waitcnt vmcnt(" #n ")" ::: "memory")
#define PG8_WAIT_L(n) asm volatile("s_waitcnt lgkmcnt(" #n ")" ::: "memory")
#define PG8_BAR __builtin_amdgcn_s_barrier()
#define PG8_SCHED __builtin_amdgcn_sched_barrier(0)
    Unit cur, nxt; int ui = 0;
    if (!S.next(0, cur)) return;
    f32x4 acc[2][2][4][2];
#pragma unroll
    for (int a = 0; a < 2; ++a)
#pragma unroll
        for (int b = 0; b < 2; ++b)
#pragma unroll
            for (int m = 0; m < 4; ++m)
#pragma unroll
                for (int n = 0; n < 2; ++n) acc[a][b][m][n] = (f32x4){0.f, 0.f, 0.f, 0.f};
    bf16x8 At[4][2], B0[2][2], B1[2][2];
    unsigned cA = (unsigned)cur.pm * (unsigned)g.tileA + (unsigned)(cur.ko >> 6) * kstepA, cB = (unsigned)cur.pn * tileB + (unsigned)(cur.ko >> 6) * kstep;
    PG8_STAGE(PG8_SB(0, 0), cB, voffB); PG8_STAGE(PG8_SB(0, 1), cB + hstepB, voffB); PG8_STAGE(PG8_SA(0, 0), cA, voffA); PG8_STAGE(PG8_SA(0, 1), cA + hstepA, voffA);
    if (wr == 1) PG8_BAR;
    PG8_WAIT_V(2); PG8_BAR;
    PG8_STAGE(PG8_SB(1, 0), cB + kstep, voffB); PG8_STAGE(PG8_SA(1, 0), cA + kstepA, voffA); PG8_STAGE(PG8_SB(1, 1), cB + hstepB + kstep, voffB);
    PG8_WAIT_V(6); PG8_BAR;
    for (;;) {
        const bool has_next = S.next(ui + 1, nxt);
        const unsigned nA = has_next ? (unsigned)nxt.pm * (unsigned)g.tileA + (unsigned)(nxt.ko >> 6) * kstepA : cA, nB = has_next ? (unsigned)nxt.pn * tileB + (unsigned)(nxt.ko >> 6) * kstep : cB;
        for (int t = 0; t < nt; t += 2) {
            const bool last = (t == nt - 2);
            const unsigned a1 = cA + (unsigned)(t + 1) * kstepA;
            const unsigned a2 = last ? nA : cA + (unsigned)(t + 2) * kstepA, b2 = last ? nB : cB + (unsigned)(t + 2) * kstep;
            const unsigned a3 = a2 + kstepA, b3 = b2 + kstep;
            PG8_LDB(B0, 0, 0); PG8_LDB(B1, 0, 1); PG8_SCHED; PG8_LDA(At, 0, 0); PG8_STAGE(PG8_SA(1, 1), a1 + hstepA, voffA);
            PG8_WAIT_V(8); PG8_WAIT_L(0); PG8_BAR; PG8_MMA(0, 0, At, B0); PG8_MMA(0, 1, At, B1); PG8_BAR; PG8_SCHED;
            PG8_LDA(At, 0, 1); PG8_STAGE(PG8_SB(0, 0), b2, voffB); PG8_STAGE(PG8_SB(0, 1), b2 + hstepB, voffB); PG8_STAGE(PG8_SA(0, 0), a2, voffA);
            PG8_WAIT_V(8); PG8_WAIT_L(0); PG8_BAR; PG8_MMA(1, 0, At, B0); PG8_MMA(1, 1, At, B1); PG8_BAR; PG8_SCHED;
            PG8_LDB(B0, 1, 0); PG8_LDB(B1, 1, 1); PG8_SCHED; PG8_LDA(At, 1, 0); PG8_STAGE(PG8_SA(0, 1), a2 + hstepA, voffA);
            PG8_WAIT_V(8); PG8_WAIT_L(0); PG8_BAR; PG8_MMA(0, 0, At, B0); PG8_MMA(0, 1, At, B1); PG8_BAR; PG8_SCHED;
            PG8_LDA(At, 1, 1); PG8_STAGE(PG8_SB(1, 0), b3, voffB); PG8_STAGE(PG8_SB(1, 1), b3 + hstepB, voffB); PG8_STAGE(PG8_SA(1, 0), a3, voffA);
            PG8_WAIT_V(8); PG8_WAIT_L(0); PG8_BAR; PG8_MMA(1, 0, At, B0); PG8_MMA(1, 1, At, B1); PG8_BAR; PG8_SCHED;
        }
        if constexpr (ALIGN_EPI) { if (wr == 0) PG8_BAR; }
        E(acc, cur, wr, wc, fr, fq);
        if (!has_next) break;
#pragma unroll
        for (int a = 0; a < 2; ++a)
#pragma unroll
            for (int b = 0; b < 2; ++b)
#pragma unroll
                for (int m = 0; m < 4; ++m)
#pragma unroll
                    for (int n = 0; n < 2; ++n) acc[a][b][m][n] = (f32x4){0.f, 0.f, 0.f, 0.f};
        cur = nxt; cA = nA; cB = nB; ++ui;
        if constexpr (ALIGN_EPI) { if (wr == 1) PG8_BAR; }
    }
    PG8_WAIT_V(0);
    if constexpr (!ALIGN_EPI) { if (wr == 0) PG8_BAR; }
    PG8_BAR;
#undef base_voffA
#undef base_voffB
#undef PG8_SA
#undef PG8_SB
#undef PG8_STAGE
#undef PG8_STAGE_
#undef PG8_LDA
#undef PG8_LDB
#undef PG8_MMA
#undef PG8_WAIT_V
#undef PG8_WAIT_L
#undef PG8_BAR
#undef PG8_SCHED
}

typedef f32x4 AccT[2][2][4][2];
struct EpiSwiglu {
    static constexpr bool PERM = true;
    bf16_t* G;
    __device__ __forceinline__ void operator()(const AccT& acc, const Unit& u, int wr, int wc, int fr, int fq) const {
        const int r0 = wr * 64 + fr, kt = u.pn * 2 + (wc >> 1), c0 = (wc & 1) * 32 + 8 * fq;
        bf16_t* blk = G + ((size_t)u.pm * (FF / 64) + kt) * (256 * 64) + c0;
#pragma unroll
        for (int ai = 0; ai < 2; ++ai)
#pragma unroll
            for (int m = 0; m < 4; ++m) {
                float v[8];
#pragma unroll
                for (int n = 0; n < 2; ++n)
#pragma unroll
                    for (int k = 0; k < 4; ++k) v[4 * n + k] = siluf_(acc[ai][0][m][n][k]) * acc[ai][1][m][n][k];
                *(u32x4*)(blk + (size_t)(r0 + ai * HALF + m * 16) * 64) = pack8(v);
            }
    }
};
struct EpiRes {
    static constexpr bool PERM = false;
    const float* resP; const float* resS; float* out; float s;
    __device__ __forceinline__ void operator()(const AccT& acc, const Unit& u, int wr, int wc, int fr, int fq) const {
        const int row0 = u.pm * BM + wr * 64 + fr, col0 = u.pn * BM + wc * 32 + 4 * fq;
        const float* res = (u.pm < 64) ? resP : resS;
#pragma unroll
        for (int ai = 0; ai < 2; ++ai) {
            f32x4 x[4][2][2];
#pragma unroll
            for (int m = 0; m < 4; ++m) { const size_t off = (size_t)(row0 + ai * HALF + m * 16) * D + col0;
#pragma unroll
                for (int bj = 0; bj < 2; ++bj)
#pragma unroll
                    for (int n = 0; n < 2; ++n) x[m][bj][n] = *(const f32x4*)(res + off + bj * HALF + n * 16); }
#pragma unroll
            for (int m = 0; m < 4; ++m) { const size_t off = (size_t)(row0 + ai * HALF + m * 16) * D + col0;
#pragma unroll
                for (int bj = 0; bj < 2; ++bj)
#pragma unroll
                    for (int n = 0; n < 2; ++n) *(f32x4*)(out + off + bj * HALF + n * 16) = x[m][bj][n] * ALPHA + acc[ai][bj][m][n] * s; }
            asm volatile("" ::: "memory"); }
    }
};
struct EpiSlab {
    static constexpr bool IDEM = true;
    static constexpr bool PERM = true;
    float* slab;
    __device__ __forceinline__ void operator()(const AccT& acc, const Unit& u, int wr, int wc, int fr, int fq) const {
        const int row0 = wr * 64 + fr, col0 = u.pn * BM + wc * 32 + 8 * fq;
        float* base = slab + (size_t)u.sub * 256 * D;
#pragma unroll
        for (int ai = 0; ai < 2; ++ai)
#pragma unroll
            for (int m = 0; m < 4; ++m) { const size_t off = (size_t)(row0 + ai * HALF + m * 16) * D + col0;
#pragma unroll
                for (int bj = 0; bj < 2; ++bj)
#pragma unroll
                    for (int n = 0; n < 2; ++n) *(f32x4*)(base + off + bj * HALF + n * 4) = acc[ai][bj][m][n]; }
    }
};
struct EpiY {
    static constexpr bool IDEM = true;
    static constexpr bool PERM = true;
    bf16_t* Y;
    __device__ __forceinline__ void operator()(const AccT& acc, const Unit& u, int wr, int wc, int fr, int fq) const {
        const int row0 = u.pm * BM + wr * 64 + fr, col0 = u.pn * BM + wc * 32 + 8 * fq;
#pragma unroll
        for (int ai = 0; ai < 2; ++ai)
#pragma unroll
            for (int m = 0; m < 4; ++m) { const int row = row0 + ai * HALF + m * 16;
#pragma unroll
                for (int bj = 0; bj < 2; ++bj) {
                    u32x4 w; w.x = pk2(acc[ai][bj][m][0][0], acc[ai][bj][m][0][1]); w.y = pk2(acc[ai][bj][m][0][2], acc[ai][bj][m][0][3]);
                    w.z = pk2(acc[ai][bj][m][1][0], acc[ai][bj][m][1][1]); w.w = pk2(acc[ai][bj][m][1][2], acc[ai][bj][m][1][3]);
                    *(u32x4*)(Y + (size_t)row * D + col0 + bj * HALF) = w; } }
    }
};
struct EpiInGate {
    static constexpr bool PERM = true;
    bf16_t* PROJ; bf16_t* GATE; const float* bgate; float* dkP; float* dvP; float* dkS; float* dvS;
    __device__ __forceinline__ void operator()(const AccT& acc, const Unit& u, int wr, int wc, int fr, int fq) const {
        const int row0 = u.pm * BM + wr * 64 + fr;
        if (u.pn < 22) {
            const int col0 = u.pn * BM + wc * 32 + 8 * fq;
            float* f32dst = nullptr; int fcol = 0;
            if (u.pn >= 16 && u.pn < 20) { const bool isk = u.pn < 18; fcol = col0 - (isk ? C_DK : C_DV);
                f32dst = (u.pm < 64) ? (isk ? dkP : dvP) : ((isk ? dkS : dvS) - (size_t)MP * 512); }
#pragma unroll
            for (int ai = 0; ai < 2; ++ai)
#pragma unroll
                for (int m = 0; m < 4; ++m) { const int row = row0 + ai * HALF + m * 16;
#pragma unroll
                    for (int bj = 0; bj < 2; ++bj) {
                        u32x4 w; w.x = pk2(acc[ai][bj][m][0][0], acc[ai][bj][m][0][1]); w.y = pk2(acc[ai][bj][m][0][2], acc[ai][bj][m][0][3]);
                        w.z = pk2(acc[ai][bj][m][1][0], acc[ai][bj][m][1][1]); w.w = pk2(acc[ai][bj][m][1][2], acc[ai][bj][m][1][3]);
                        *(u32x4*)(PROJ + (size_t)row * NIN + col0 + bj * HALF) = w;
                        if (f32dst) { float* p = f32dst + (size_t)row * 512 + fcol + bj * HALF; *(f32x4*)p = acc[ai][bj][m][0]; *(f32x4*)(p + 4) = acc[ai][bj][m][1]; }
                    } }
        } else {
            const int col0 = (u.pn - 22) * BM + wc * 32 + 8 * fq;
            const unsigned lane16 = (unsigned)(((wr * 4 + wc) * 4 + fq) * 16 + fr) * 16u;
            bf16_t* gtile = GATE + ((size_t)u.pm * 32 + (u.pn - 22)) * 65536;
            f32x4 bv[2][2];
#pragma unroll
            for (int bj = 0; bj < 2; ++bj)
#pragma unroll
                for (int n = 0; n < 2; ++n) bv[bj][n] = *(const f32x4*)(bgate + col0 + bj * HALF + 4 * n);
#pragma unroll
            for (int ai = 0; ai < 2; ++ai)
#pragma unroll
                for (int m = 0; m < 4; ++m) { const int row = row0 + ai * HALF + m * 16;
#pragma unroll
                    for (int bj = 0; bj < 2; ++bj) { float v[8];
#pragma unroll
                        for (int n = 0; n < 2; ++n)
#pragma unroll
                            for (int k = 0; k < 4; ++k) v[4 * n + k] = sigmoidf_(acc[ai][bj][m][n][k] + bv[bj][n][k]);
                        *(u32x4*)(((char*)gtile + ((ai * 4 + m) * 2 + bj) * 8192) + (size_t)lane16) = pack8(v); } }
        }
    }
};
struct EpiMemKV {
    static constexpr bool PERM = true;
    bf16_t* MKV; float* mk; float* mv;
    __device__ __forceinline__ void operator()(const AccT& acc, const Unit& u, int wr, int wc, int fr, int fq) const {
        const int row0 = u.pm * BM + wr * 64 + fr, col0 = u.pn * BM + wc * 32 + 8 * fq;
        float* dst = (u.pn < 2) ? mk : mv; const int fcol = col0 - (u.pn < 2 ? 0 : 512);
#pragma unroll
        for (int ai = 0; ai < 2; ++ai)
#pragma unroll
            for (int m = 0; m < 4; ++m) { const int row = row0 + ai * HALF + m * 16;
#pragma unroll
                for (int bj = 0; bj < 2; ++bj) {
                    u32x4 w; w.x = pk2(acc[ai][bj][m][0][0], acc[ai][bj][m][0][1]); w.y = pk2(acc[ai][bj][m][0][2], acc[ai][bj][m][0][3]);
                    w.z = pk2(acc[ai][bj][m][1][0], acc[ai][bj][m][1][1]); w.w = pk2(acc[ai][bj][m][1][2], acc[ai][bj][m][1][3]);
                    *(u32x4*)(MKV + (size_t)row * 1024 + col0 + bj * HALF) = w;
                    float* p = dst + (size_t)row * 512 + fcol + bj * HALF; *(f32x4*)p = acc[ai][bj][m][0]; *(f32x4*)(p + 4) = acc[ai][bj][m][1];
                } }
    }
};
struct EpiBranch {
    static constexpr bool IDEM = false;
    static constexpr bool PERM = true;
    bf16_t* GATE; bf16_t* MERGED;
    __device__ __forceinline__ void operator()(const AccT& acc, const Unit& u, int wr, int wc, int fr, int fq) const {
        const int row0 = u.pm * BM + wr * 64 + fr, col0 = u.pn * BM + wc * 32 + 8 * fq;
        const unsigned lane16 = (unsigned)(((wr * 4 + wc) * 4 + fq) * 16 + fr) * 16u;
        const char* gtile = (const char*)(GATE + ((size_t)u.pm * 32 + u.sub * 8 + u.pn) * 65536);
        const char* otile = gtile - (size_t)8 * 65536 * 2;
        bf16_t* mrow = MERGED + (size_t)row0 * D + col0;
#pragma unroll
        for (int ai = 0; ai < 2; ++ai)
#pragma unroll
          for (int mh = 0; mh < 2; ++mh) {
            u32x4 gw[2][2], ow[2][2];
#pragma unroll
            for (int m2 = 0; m2 < 2; ++m2) { const int m = 2 * mh + m2;
#pragma unroll
                for (int bj = 0; bj < 2; ++bj) { gw[m2][bj] = *(const u32x4*)((gtile + ((ai * 4 + m) * 2 + bj) * 8192) + (size_t)lane16);
                    if (u.sub != 0) ow[m2][bj] = *(const u32x4*)((otile + ((ai * 4 + m) * 2 + bj) * 8192) + (size_t)lane16); } }
#pragma unroll
            for (int m2 = 0; m2 < 2; ++m2) { const int m = 2 * mh + m2;
#pragma unroll
                for (int bj = 0; bj < 2; ++bj) {
                    float gt[8], v[8];
                    unpack8(gw[m2][bj], gt);
#pragma unroll
                    for (int n = 0; n < 2; ++n)
#pragma unroll
                        for (int k = 0; k < 4; ++k) v[4 * n + k] = gt[4 * n + k] * acc[ai][bj][m][n][k];
                    if (u.sub != 0) { float old[8]; unpack8(ow[m2][bj], old);
#pragma unroll
                        for (int k = 0; k < 8; ++k) v[k] += old[k]; }
                    if (u.sub == 3) *(u32x4*)(mrow + (size_t)(ai * HALF + m * 16) * D + bj * HALF) = pack8(v);
                    else *(u32x4*)(((char*)gtile + ((ai * 4 + m) * 2 + bj) * 8192) + (size_t)lane16) = pack8(v);
                } }
            asm volatile("" ::: "memory");
          }
    }
};
struct EpiBranchS {
    static constexpr bool IDEM = true;
    static constexpr bool PERM = true;
    const bf16_t* GATE; bf16_t* P;
    __device__ __forceinline__ void operator()(const AccT& acc, const Unit& u, int wr, int wc, int fr, int fq) const {
        const int r0 = wr * 64 + fr, col0 = u.pn * BM + wc * 32 + 8 * fq;
        const unsigned lane16 = (unsigned)(((wr * 4 + wc) * 4 + fq) * 16 + fr) * 16u;
        const char* gtile = (const char*)(GATE + ((size_t)u.pm * 32 + u.sub * 8 + u.pn) * 65536);
#pragma unroll
        for (int ai = 0; ai < 2; ++ai) {
            u32x4 gw[4][2];
#pragma unroll
            for (int m = 0; m < 4; ++m)
#pragma unroll
                for (int bj = 0; bj < 2; ++bj) gw[m][bj] = *(const u32x4*)((gtile + ((ai * 4 + m) * 2 + bj) * 8192) + (size_t)lane16);
#pragma unroll
            for (int m = 0; m < 4; ++m) { const int rp = r0 + ai * HALF + m * 16;
#pragma unroll
                for (int bj = 0; bj < 2; ++bj) {
                    float gt[8], v[8];
                    unpack8(gw[m][bj], gt);
#pragma unroll
                    for (int n = 0; n < 2; ++n)
#pragma unroll
                        for (int k = 0; k < 4; ++k) v[4 * n + k] = gt[4 * n + k] * acc[ai][bj][m][n][k];
                    *(u32x4*)(P + ((size_t)u.sub * 256 + rp) * D + col0 + bj * HALF) = pack8(v);
                } }
            asm volatile("" ::: "memory");
        }
    }
};
}

#define XB_TMO      128
#define XB_XCNT(j)  (256  + 64 * (j))
#define XB_XSUB(j)  (1280 + 64 * (j))
#define XB_XGEN(j)  (2304 + 64 * (j))
#define XB_TOP      3328
#define XB_TOPGEN   3392
#define XCD_BAR_WORDS 3456
#define XB_SPIN_CAP (1u << 18)
__device__ __forceinline__ unsigned xb_ld(unsigned* p)              { return __hip_atomic_load(p, __ATOMIC_RELAXED, __HIP_MEMORY_SCOPE_AGENT); }
__device__ __forceinline__ unsigned xb_add(unsigned* p, unsigned v) { return __hip_atomic_fetch_add(p, v, __ATOMIC_RELAXED, __HIP_MEMORY_SCOPE_AGENT); }
__device__ __forceinline__ unsigned xb_xcc_id() { return (unsigned)__builtin_amdgcn_s_getreg((3 << 11) | 20) & 0xFu; }
#define XB_SPIN(cond, bar) do { unsigned _sp = 0; while (cond) { __builtin_amdgcn_s_sleep(1); \
    if ((++_sp & 255u) == 0u) { if (xb_ld(&(bar)[XB_TMO])) break; if (_sp > XB_SPIN_CAP) { atomicAdd(&(bar)[XB_TMO], 1u); break; } } } } while (0)
struct XcdBarrier { unsigned* bar; unsigned x; volatile LAS unsigned* st; };
__device__ __forceinline__ XcdBarrier xcd_barrier_post(unsigned* bar, volatile LAS unsigned* st) {
    XcdBarrier b; b.bar = bar; b.x = xb_xcc_id(); b.st = st;
    if (threadIdx.x == 0) (void)xb_add(&bar[XB_XCNT(b.x)], 1u);
    return b;
}
__device__ __forceinline__ void xcd_barrier_complete(unsigned* bar, unsigned x, unsigned& nloc, unsigned& nx) {
    const unsigned G = gridDim.x * gridDim.y * gridDim.z;
    unsigned sum, cnt, mine, sp = 0u;
    for (;;) {
        sum = 0u; cnt = 0u; mine = 0u;
#pragma unroll
        for (unsigned j = 0; j < 16; ++j) { const unsigned c = xb_ld(&bar[XB_XCNT(j)]); sum += c; cnt += (c > 0u) ? 1u : 0u; mine = (j == x) ? c : mine; }
        if (sum == G) break;
        __builtin_amdgcn_s_sleep(1);
        if ((++sp & 255u) == 0u) { if (xb_ld(&bar[XB_TMO])) break; if (sp > XB_SPIN_CAP) { atomicAdd(&bar[XB_TMO], 1u); break; } }
    }
    nloc = mine > 0u ? mine : 1u; nx = cnt > 0u ? cnt : 1u;
}
__device__ __forceinline__ void xcd_barrier(const XcdBarrier& b) {
    asm volatile("s_waitcnt vmcnt(0)" ::: "memory");
    __syncthreads();
    if (threadIdx.x == 0) {
        unsigned* bar = b.bar;
        __builtin_amdgcn_s_waitcnt(0);
        unsigned nloc = b.st[0], nx = b.st[1];
        if (nloc == 0u) { xcd_barrier_complete(bar, b.x, nloc, nx); b.st[0] = nloc; b.st[1] = nx; }
        const unsigned old = xb_add(&bar[XB_XSUB(b.x)], 1u);
        const unsigned gen = old / nloc;
        if (old + 1u == (gen + 1u) * nloc) {
            __builtin_amdgcn_fence(__ATOMIC_RELEASE, "agent");
            asm volatile("s_waitcnt vmcnt(0)" ::: "memory");
            const unsigned og = xb_add(&bar[XB_TOP], 1u);
            const unsigned tg = og / nx;
            if (og + 1u == (tg + 1u) * nx) xb_add(&bar[XB_TOPGEN], 1u);
            else XB_SPIN(xb_ld(&bar[XB_TOPGEN]) == tg, bar);
            __builtin_amdgcn_fence(__ATOMIC_ACQUIRE, "agent");
            xb_add(&bar[XB_XGEN(b.x)], 1u);
            asm volatile("s_waitcnt vmcnt(0)" ::: "memory");
        } else {
            XB_SPIN(xb_ld(&bar[XB_XGEN(b.x)]) == gen, bar);
            __builtin_amdgcn_fence(__ATOMIC_ACQUIRE, "agent");
            asm volatile("s_waitcnt vmcnt(0)" ::: "memory");
        }
    }
    __syncthreads();
}

struct Args {
    const float* in[30]; float* out; unsigned char* ws; int ph_lo, ph_hi;
};
struct Frame {
    LAS unsigned char* lds; LAS unsigned char* aux; volatile LAS unsigned* MISC;
    gu32* ctl; int tid, lane, wave, G, bid;
    unsigned char* ws; float* out;
    float lam, omi;
};
constexpr int AUX_TBL = 4096;
DI const float* inp(const Frame& F, int k) {
    const LAS unsigned* t = (const LAS unsigned*)(F.aux + AUX_TBL) + 2 * k;
    const unsigned lo = (unsigned)__builtin_amdgcn_readfirstlane((int)t[0]), hi = (unsigned)__builtin_amdgcn_readfirstlane((int)t[1]);
    return (const float*)(const GAS float*)(((unsigned long long)hi << 32) | lo);
}
enum { I_XP = 0, I_XS, I_SCONV, I_SRET, I_CDK, I_CDV, I_CMK, I_CMV, I_MEMP, I_UP1, I_DN1, I_LN1G, I_LN1B, I_WIN, I_CONVW, I_RETG, I_DLAM, I_DSUB, I_WMKV, I_WBR, I_WGATE, I_BGATE, I_WO,
       I_LN2G, I_LN2B, I_UP2, I_DN2, I_LN3G, I_LN3B, I_RELB };

DI int wq_next(Frame& F, int k) {
    __syncthreads();
    if (F.tid == 0) F.MISC[0] = __hip_atomic_fetch_add((unsigned*)(F.ctl + CW_WQ + 64 * k), 1u, RLX_AGENT);
    __syncthreads();
    return __builtin_amdgcn_readfirstlane((int)F.MISC[0]);
}

DI void p0_transpose_item(const float* W, int N, int k0, int n0, bf16* WT, int ldk, int dst_row0, int kofs, LAS float* scr, int lane) {
    const int c4 = lane & 15, rr = lane >> 4;
#pragma unroll 4
    for (int i = 0; i < 16; ++i) { const int kk = 4 * i + rr; const f32x4 v = *(const f32x4*)(W + (size_t)(k0 + kk) * N + n0 + 4 * c4);
        LAS float* d = scr + kk * 65 + 4 * c4; d[0] = v.x; d[1] = v.y; d[2] = v.z; d[3] = v.w; }
    LDS_WAIT(); asm volatile("" ::: "memory");
    const int rs = lane & 15, ch = lane >> 4;
#pragma unroll
    for (int j = 0; j < 8; ++j) { const int sg = j >> 1, kh = j & 1;
        const int rho = 16 * (sg & 1) + rs, q = 32 * (sg >> 1) + pg8::perm32(rho);
        const LAS float* sp = scr + (32 * kh + 8 * ch) * 65 + q;
        u32x4 o; o.x = pk2(sp[0 * 65], sp[1 * 65]); o.y = pk2(sp[2 * 65], sp[3 * 65]); o.z = pk2(sp[4 * 65], sp[5 * 65]); o.w = pk2(sp[6 * 65], sp[7 * 65]);
        const int R0 = dst_row0, k = kofs + k0 + 32 * kh + 8 * ch;
        const int slot = (R0 & 64) + 32 * (sg >> 1) + rho;
        const size_t off = ((size_t)((R0 >> 8) * (ldk >> 6) + (k >> 6)) * 2 + ((R0 >> 7) & 1)) * 16384 + pg8::lds_byte(slot, k & 63);
        *(u32x4*)((char*)WT + off) = o; }
    LDS_WAIT(); asm volatile("" ::: "memory");
}
DI void p0_matrix(const float* W, int K, int N, int r, bf16* WT, int ldk, int mode, int row_base, int kofs, LAS float* scr, int lane) {
    const int nblk = N / 64, kb = r / nblk, nb = r - kb * nblk, n0 = 64 * nb;
    int drow = row_base + n0;
    if (mode == 1) { const int isb = n0 >= FF, nn = n0 - (isb ? FF : 0); drow = 256 * (nn >> 7) + (isb ? 128 : 0) + (nn & 127); }
    p0_transpose_item(W, N, 64 * kb, n0, WT, ldk, drow, kofs, scr, lane);
}
DI void p0_prologue(Frame& F, const Args& a, unsigned char* ws) {
    LAS float* scr = (LAS float*)(F.lds + F.wave * 16640);
    const int gw = F.bid * 8 + F.wave, NGW = F.G * 8;
    constexpr int I_UP = (D / 64) * (NUP / 64), I_DN = (FF / 64) * (D / 64), I_IN = (D / 64) * (NIN / 64), I_GT = 4 * (D / 64) * (D / 64), I_MK = (D / 64) * (1024 / 64),
                  I_BR = 4 * (512 / 64) * (D / 64), I_O = (D / 64) * (D / 64);
    constexpr int PER_LAYER = 2 * I_UP + 2 * I_DN + I_IN + I_GT + I_MK + I_BR + I_O;
    for (int it = gw; it < 2 * PER_LAYER; it += NGW) {
        const int l = it / PER_LAYER; int r = it - l * PER_LAYER;
        unsigned char* wl = ws + WS_W + (size_t)l * LAYER_W;
        if (r < I_UP) { p0_matrix(inp(F, I_UP1) + (size_t)l * D * NUP, D, NUP, r, (bf16*)(wl + W_UP1), D, 1, 0, 0, scr, F.lane); continue; } r -= I_UP;
        if (r < I_DN) { p0_matrix(inp(F, I_DN1) + (size_t)l * FF * D, FF, D, r, (bf16*)(wl + W_DN1), FF, 0, 0, 0, scr, F.lane); continue; } r -= I_DN;
        if (r < I_IN) { p0_matrix(inp(F, I_WIN) + (size_t)l * D * NIN, D, NIN, r, (bf16*)(wl + W_IG), D, 0, 0, 0, scr, F.lane); continue; } r -= I_IN;
        if (r < I_GT) { const int i = r / (I_GT / 4), rr = r - i * (I_GT / 4);
            p0_matrix(inp(F, I_WGATE) + ((size_t)l * 4 + i) * D * D, D, D, rr, (bf16*)(wl + W_IG), D, 0, NIN + i * D, 0, scr, F.lane); continue; } r -= I_GT;
        if (r < I_MK) { p0_matrix(inp(F, I_WMKV) + (size_t)l * D * 1024, D, 1024, r, (bf16*)(wl + W_MKV), D, 0, 0, 0, scr, F.lane); continue; } r -= I_MK;
        if (r < I_BR) { const int i = r / (I_BR / 4), rr = r - i * (I_BR / 4);
            p0_matrix(inp(F, I_WBR) + ((size_t)l * 4 + i) * 512 * D, 512, D, rr, (bf16*)(wl + W_BR), D, 0, 0, i * 512, scr, F.lane); continue; } r -= I_BR;
        if (r < I_O) { p0_matrix(inp(F, I_WO) + (size_t)l * D * D, D, D, r, (bf16*)(wl + W_WO), D, 0, 0, 0, scr, F.lane); continue; } r -= I_O;
        if (r < I_UP) { p0_matrix(inp(F, I_UP2) + (size_t)l * D * NUP, D, NUP, r, (bf16*)(wl + W_UP2), D, 1, 0, 0, scr, F.lane); continue; } r -= I_UP;
        p0_matrix(inp(F, I_DN2) + (size_t)l * FF * D, FF, D, r, (bf16*)(wl + W_DN2), FF, 0, 0, 0, scr, F.lane);
    }
    {
        const size_t gt = (size_t)F.bid * 512 + F.tid, NT = (size_t)F.G * 512;
        bf16* XB = (bf16*)(ws + WS_XB); bf16* MX = (bf16*)(ws + WS_MEMX);
        const size_t nP = (size_t)MP * D / 8, nS = (size_t)MS * D / 8, nM = (size_t)1024 * D / 8;
        for (size_t i = gt; i < nP + nS + nM; i += NT) {
            const float* src; bf16* dst;
            if (i < nP) { src = inp(F, I_XP) + i * 8; dst = XB + i * 8; }
            else if (i < nP + nS) { src = inp(F, I_XS) + (i - nP) * 8; dst = XB + i * 8; }
            else { src = inp(F, I_MEMP) + (i - nP - nS) * 8; dst = MX + (i - nP - nS) * 8; }
            const f32x4 v0 = *(const f32x4*)src, v1 = *(const f32x4*)(src + 4);
            u32x4 w; w.x = pk2(v0.x, v0.y); w.y = pk2(v0.z, v0.w); w.z = pk2(v1.x, v1.y); w.w = pk2(v1.z, v1.w);
            *(u32x4*)dst = w;
        }
        float* rc = (float*)(ws + WS_ROPE); float* rs = rc + 4096 * 64;
        for (size_t i = gt; i < (size_t)4096 * 64; i += NT) {
            const int pos = (int)(i >> 6), j = (int)(i & 63);
            const double invrev = exp2(-(double)j * (13.287712379549449 / 64.0)) * 0.15915494309189535;
            double rev = (double)pos * invrev; rev -= floor(rev);
            const float rf = (float)rev;
            rc[i] = __builtin_amdgcn_cosf(rf); rs[i] = __builtin_amdgcn_sinf(rf);
        }
    }
}

template <bool RESF32>
DI void ln_phase(Frame& F, const void* resP, const void* resS, const bf16* Y, float* outP, float* outS, bf16* XB, const float* g, const float* b, const float* slab, int nslab, float sscale) {
    const int gw = F.bid * 8 + F.wave, NGW = F.G * 8;
    f32x4 gv[8], bv[8];
#pragma unroll
    for (int j = 0; j < 8; ++j) { gv[j] = *(const f32x4*)(g + 4 * F.lane + 256 * j); bv[j] = *(const f32x4*)(b + 4 * F.lane + 256 * j); }
    for (int m = gw; m < M; m += NGW) {
        f32x4 v[8]; float s = 0.f;
        const bool samp = m >= MP;
        if (RESF32) { const f32x4* rr = (const f32x4*)((const float*)(samp ? resS : resP) + (size_t)(samp ? m - MP : m) * D) + F.lane;
#pragma unroll
            for (int j = 0; j < 8; ++j) v[j] = rr[64 * j] * ALPHA;
        } else { const u32x2* rr = (const u32x2*)((const bf16*)(samp ? resS : resP) + (size_t)(samp ? m - MP : m) * D) + F.lane;
#pragma unroll
            for (int j = 0; j < 8; ++j) { const u32x2 x = rr[64 * j]; v[j] = (f32x4){bf_lo(x.x), bf_hi(x.x), bf_lo(x.y), bf_hi(x.y)} * ALPHA; } }
        if (samp) {
            f32x4 acc[8];
#pragma unroll
            for (int j = 0; j < 8; ++j) acc[j] = (f32x4){0.f, 0.f, 0.f, 0.f};
#pragma unroll 4
            for (int k = 0; k < nslab; ++k) { const f32x4* sr = (const f32x4*)(slab + ((size_t)k * 256 + (m - MP)) * D) + F.lane;
#pragma unroll
                for (int j = 0; j < 8; ++j) acc[j] += sr[64 * j]; }
#pragma unroll
            for (int j = 0; j < 8; ++j) v[j] += acc[j] * sscale;
        } else {
            const u32x2* yr = (const u32x2*)(Y + (size_t)m * D) + F.lane;
#pragma unroll
            for (int j = 0; j < 8; ++j) { const u32x2 y = yr[64 * j]; v[j] += (f32x4){bf_lo(y.x), bf_hi(y.x), bf_lo(y.y), bf_hi(y.y)} * sscale; }
        }
#pragma unroll
        for (int j = 0; j < 8; ++j) s += (v[j].x + v[j].y) + (v[j].z + v[j].w);
        const float mean = wave_sum(s) * (1.f / D); float s2 = 0.f;
#pragma unroll
        for (int j = 0; j < 8; ++j) { v[j] = v[j] - mean; s2 += (v[j].x * v[j].x + v[j].y * v[j].y) + (v[j].z * v[j].z + v[j].w * v[j].w); }
        const float rstd = 1.f / sqrtf(wave_sum(s2) * (1.f / D) + LN_EPS);
        float* orow = outP ? (samp ? outS + (size_t)(m - MP) * D : outP + (size_t)m * D) : nullptr;
#pragma unroll
        for (int j = 0; j < 8; ++j) { const f32x4 o = v[j] * rstd * gv[j] + bv[j];
            if (orow) *((f32x4*)orow + F.lane + 64 * j) = o;
            if (XB) { u32x2 w; w.x = pk2(o.x, o.y); w.y = pk2(o.z, o.w); *((u32x2*)(XB + (size_t)m * D) + F.lane + 64 * j) = w; } }
    }
}

DI float gamma_log2(int h) { return h == 0 ? -0.045803689613124746f : h == 1 ? -0.022720076500083512f : h == 2 ? -0.011315313227834106f : -0.005646563141142085f; }
#define MFMA16(a, b, c) __builtin_amdgcn_mfma_f32_16x16x32_bf16((a), (b), (c), 0, 0, 0)
#define MFMA32(a, b, c) __builtin_amdgcn_mfma_f32_32x32x16_bf16((a), (b), (c), 0, 0, 0)

DI void rope8(const bf16* src  , int cp, const float* rc, const float* rs, int pos, float* o1, float* o2) {
    float x1[8], x2[8];
    unpack8(*(const u32x4*)(src + 8 * cp), x1); unpack8(*(const u32x4*)(src + 64 + 8 * cp), x2);
    const f32x4 c0 = *(const f32x4*)(rc + pos * 64 + 8 * cp), c1 = *(const f32x4*)(rc + pos * 64 + 8 * cp + 4);
    const f32x4 s0 = *(const f32x4*)(rs + pos * 64 + 8 * cp), s1 = *(const f32x4*)(rs + pos * 64 + 8 * cp + 4);
    const float cs[8] = {c0.x, c0.y, c0.z, c0.w, c1.x, c1.y, c1.z, c1.w}, sn[8] = {s0.x, s0.y, s0.z, s0.w, s1.x, s1.y, s1.z, s1.w};
#pragma unroll
    for (int j = 0; j < 8; ++j) { o1[j] = x1[j] * cs[j] - x2[j] * sn[j]; o2[j] = x2[j] * cs[j] + x1[j] * sn[j]; }
}
DI void lds_st16(LAS unsigned char* p, float v) { *(LAS unsigned short*)p = (unsigned short)(pk2(v, 0.f) & 0xffffu); }

DI void conv_task(Frame& F, const Args& a, int l, int task) {
    const bf16* PROJ = (const bf16*)(F.ws + WS_G); bf16* Y = (bf16*)(F.ws + WS_Y);
    const float* cw = inp(F, I_CONVW) + (size_t)l * 3 * 512;
    const int c0 = 8 * F.lane, r0 = task * 256 + F.wave * 32;
    float w0[8], w1[8], w2[8];
#pragma unroll
    for (int j = 0; j < 8; ++j) { w0[j] = cw[c0 + j]; w1[j] = cw[512 + c0 + j]; w2[j] = cw[1024 + c0 + j]; }
    float um1[8], um2[8];
#pragma unroll
    for (int j = 0; j < 8; ++j) { um1[j] = 0.f; um2[j] = 0.f; }
    for (int rr = -2; rr < 32; ++rr) {
        const int row = r0 + rr;
        const bool samp = row >= MP;
        const int tl = samp ? ((row - MP) & 15) : (row & 4095);
        if (rr < 0) { if (row < 0 || (r0 >= MP && row < MP)) continue; if ((samp ? ((r0 - MP) & 15) : (r0 & 4095)) + rr < 0) continue; }
        if (rr >= 0 && tl == 0) {
            if (!samp) {
#pragma unroll
                for (int j = 0; j < 8; ++j) { um1[j] = 0.f; um2[j] = 0.f; }
            } else { const float* sc = inp(F, I_SCONV) + (((size_t)l * 16 + ((row - MP) >> 4)) * 2) * 512 + c0;
#pragma unroll
                for (int j = 0; j < 8; ++j) { um2[j] = sc[j]; um1[j] = sc[512 + j]; } }
        }
        float cc[8], ch[8], u[8];
        unpack8(*(const u32x4*)(PROJ + (size_t)row * NIN + C_CC + c0), cc); unpack8(*(const u32x4*)(PROJ + (size_t)row * NIN + C_CH + c0), ch);
#pragma unroll
        for (int j = 0; j < 8; ++j) u[j] = cc[j] * ch[j];
        if (rr >= 0) {
            float cb[8], y[8]; unpack8(*(const u32x4*)(PROJ + (size_t)row * NIN + C_CB + c0), cb);
#pragma unroll
            for (int j = 0; j < 8; ++j) y[j] = cb[j] * (w0[j] * um2[j] + w1[j] * um1[j] + w2[j] * u[j]);
            *(u32x4*)(Y + (size_t)row * D + c0) = pack8(y);
            const int L = samp ? DSEQ : SEQ;
            if (tl >= L - 2) {
                float* dst = samp ? F.out + O_CONVS + (((size_t)l * 16 + ((row - MP) >> 4)) * 2 + (tl - (L - 2))) * 512 + c0
                                  : F.out + O_CONVP + (((size_t)l * 4 + (row >> 12)) * 2 + (tl - (L - 2))) * 512 + c0;
                *(f32x4*)dst = (f32x4){u[0], u[1], u[2], u[3]}; *(f32x4*)(dst + 4) = (f32x4){u[4], u[5], u[6], u[7]};
            }
        }
#pragma unroll
        for (int j = 0; j < 8; ++j) { um2[j] = um1[j]; um1[j] = u[j]; }
    }
}

constexpr int R1_KT = 0, R1_VT = 18432;
DI void ret1_task(Frame& F, const Args& a, int l, int unit) {
    const bf16* PROJ = (const bf16*)(F.ws + WS_G); float* RETKV = (float*)(F.ws + WS_XA);
    const float* rc = (const float*)(F.ws + WS_ROPE); const float* rs = rc + 4096 * 64;
    const int bh = unit >> 6, c = unit & 63, b = bh >> 2, h = bh & 3;
    const int row0 = b * SEQ + c * 64;
    const float lg = gamma_log2(h);
    {
        const int tok = F.tid >> 3, cp = F.tid & 7;
        float o1[8], o2[8];
        rope8(PROJ + (size_t)(row0 + tok) * NIN + C_RK + h * 128, cp, rc, rs, c * 64 + tok, o1, o2);
        const float sc = 0.08838834764831845f * fexp2(lg * (float)(63 - tok));
#pragma unroll
        for (int j = 0; j < 8; ++j) { lds_st16(F.lds + R1_KT + (8 * cp + j) * 144 + tok * 2, o1[j] * sc); lds_st16(F.lds + R1_KT + (64 + 8 * cp + j) * 144 + tok * 2, o2[j] * sc); }
#pragma unroll
        for (int i = 0; i < 2; ++i) { const int id = F.tid + 512 * i, tk = id >> 4, chn = id & 15;
            const u32x4 v = *(const u32x4*)(PROJ + (size_t)(row0 + tk) * NIN + C_RV + h * 128 + 8 * chn);
            const unsigned w[4] = {v.x, v.y, v.z, v.w};
#pragma unroll
            for (int j = 0; j < 4; ++j) { *(LAS unsigned short*)(F.lds + R1_VT + (8 * chn + 2 * j) * 144 + tk * 2) = (unsigned short)(w[j] & 0xffffu);
                                          *(LAS unsigned short*)(F.lds + R1_VT + (8 * chn + 2 * j + 1) * 144 + tk * 2) = (unsigned short)(w[j] >> 16); } }
    }
    __syncthreads();
    const int r16 = F.lane & 15, g = F.lane >> 4, w = F.wave;
    bf16x8 af[2];
#pragma unroll
    for (int ks = 0; ks < 2; ++ks) af[ks] = *(const LAS bf16x8*)(F.lds + R1_VT + (16 * w + r16) * 144 + (32 * ks + 8 * g) * 2);
    float* dst = RETKV + (size_t)unit * 16384;
#pragma unroll
    for (int dt = 0; dt < 8; ++dt) {
        f32x4 acc = {0.f, 0.f, 0.f, 0.f};
#pragma unroll
        for (int ks = 0; ks < 2; ++ks) { const bf16x8 bfr = *(const LAS bf16x8*)(F.lds + R1_KT + (16 * dt + r16) * 144 + (32 * ks + 8 * g) * 2); acc = MFMA16(af[ks], bfr, acc); }
#pragma unroll
        for (int r = 0; r < 4; ++r) dst[(16 * w + 4 * g + r) * 128 + 16 * dt + r16] = acc[r];
    }
}

DI void ret2_task(Frame& F, const Args& a, int l, int task) {
    const float* RETKV = (const float*)(F.ws + WS_XA); bf16* RETS = (bf16*)(F.ws + WS_RETS);
    const int bh = task >> 4, eb = task & 15, h = bh & 3;
    const int e = eb * 8 + (F.tid >> 6), d = 2 * (F.tid & 63);
    const float cdec = fexp2(gamma_log2(h) * 64.f);
    float s0 = 0.f, s1 = 0.f;
    const size_t base = ((size_t)bh * 64) * 16384 + e * 128 + d;
#pragma unroll 8
    for (int c = 0; c < 64; ++c) {
        const f32x2 v = *(const f32x2*)(RETKV + base + (size_t)c * 16384);
        *(unsigned*)(RETS + base + (size_t)c * 16384) = pk2(s0, s1);
        s0 = s0 * cdec + v.x; s1 = s1 * cdec + v.y;
    }
    float* o = F.out + O_RETP + ((size_t)l * 16 + bh) * 16384;
    o[d * 128 + e] = s0; o[(d + 1) * 128 + e] = s1;
}

constexpr int R3_Q = 0, R3_K = 17408, R3_VT = 34816, R3_ST = 53248, R3_ATT = 88064, R3_OF = 97280;
DI void ret_norm_store(Frame& F, const Args& a, int l, int h, int rowbase, int nrows, int of_off) {
    const bf16* PROJ = (const bf16*)(F.ws + WS_G); bf16* Y = (bf16*)(F.ws + WS_Y);
    const int i = F.tid >> 3, part = F.tid & 7;
    if (i < nrows) {
        const LAS float* of = (const LAS float*)(F.lds + of_off) + i * 132 + 16 * part;
        float x[16]; float s = 0.f;
#pragma unroll
        for (int k = 0; k < 16; ++k) { x[k] = of[k]; s += x[k]; }
        s += __shfl_xor(s, 1); s += __shfl_xor(s, 2); s += __shfl_xor(s, 4);
        const float mu = s * (1.f / 128.f); float q = 0.f;
#pragma unroll
        for (int k = 0; k < 16; ++k) { x[k] -= mu; q += x[k] * x[k]; }
        q += __shfl_xor(q, 1); q += __shfl_xor(q, 2); q += __shfl_xor(q, 4);
        const float rstd = 1.f / sqrtf(q * (1.f / 128.f) + LN_EPS);
        const float* gg = inp(F, I_RETG) + (size_t)l * 512 + h * 128 + 16 * part;
        const size_t row = (size_t)rowbase + i;
        float rg[16]; unpack8(*(const u32x4*)(PROJ + row * NIN + C_RG + h * 128 + 16 * part), rg); unpack8(*(const u32x4*)(PROJ + row * NIN + C_RG + h * 128 + 16 * part + 8), rg + 8);
        float y[16];
#pragma unroll
        for (int k = 0; k < 16; ++k) y[k] = siluf_(rg[k]) * (x[k] * rstd * gg[k]);
        *(u32x4*)(Y + row * D + 512 + h * 128 + 16 * part) = pack8(y); *(u32x4*)(Y + row * D + 512 + h * 128 + 16 * part + 8) = pack8(y + 8);
    }
}
DI void ret3_task(Frame& F, const Args& a, int l, int unit) {
    const bf16* PROJ = (const bf16*)(F.ws + WS_G); const bf16* RETS = (const bf16*)(F.ws + WS_RETS);
    const float* rc = (const float*)(F.ws + WS_ROPE); const float* rs = rc + 4096 * 64;
    const int bh = unit >> 6, c = unit & 63, b = bh >> 2, h = bh & 3;
    const int row0 = b * SEQ + c * 64;
    const float lg = gamma_log2(h);
    {
        const int tok = F.tid >> 3, cp = F.tid & 7;
        float o1[8], o2[8];
        rope8(PROJ + (size_t)(row0 + tok) * NIN + C_RQ + h * 128, cp, rc, rs, c * 64 + tok, o1, o2);
        *(LAS u32x4*)(F.lds + R3_Q + tok * 272 + 16 * cp) = pack8(o1); *(LAS u32x4*)(F.lds + R3_Q + tok * 272 + 128 + 16 * cp) = pack8(o2);
        rope8(PROJ + (size_t)(row0 + tok) * NIN + C_RK + h * 128, cp, rc, rs, c * 64 + tok, o1, o2);
#pragma unroll
        for (int j = 0; j < 8; ++j) { o1[j] *= 0.08838834764831845f; o2[j] *= 0.08838834764831845f; }
        *(LAS u32x4*)(F.lds + R3_K + tok * 272 + 16 * cp) = pack8(o1); *(LAS u32x4*)(F.lds + R3_K + tok * 272 + 128 + 16 * cp) = pack8(o2);
#pragma unroll
        for (int i = 0; i < 2; ++i) { const int id = F.tid + 512 * i, tk = id >> 4, chn = id & 15;
            const u32x4 v = *(const u32x4*)(PROJ + (size_t)(row0 + tk) * NIN + C_RV + h * 128 + 8 * chn);
            const unsigned w[4] = {v.x, v.y, v.z, v.w};
#pragma unroll
            for (int j = 0; j < 4; ++j) { *(LAS unsigned short*)(F.lds + R3_VT + (8 * chn + 2 * j) * 144 + tk * 2) = (unsigned short)(w[j] & 0xffffu);
                                          *(LAS unsigned short*)(F.lds + R3_VT + (8 * chn + 2 * j + 1) * 144 + tk * 2) = (unsigned short)(w[j] >> 16); } }
#pragma unroll
        for (int i = 0; i < 4; ++i) { const int id = F.tid + 512 * i, e = id >> 4, chn = id & 15;
            *(LAS u32x4*)(F.lds + R3_ST + e * 272 + 16 * chn) = *(const u32x4*)(RETS + (size_t)unit * 16384 + e * 128 + 8 * chn); }
    }
    __syncthreads();
    const int r16 = F.lane & 15, g = F.lane >> 4, w = F.wave, rb = w & 3, hw = w >> 2;
    bf16x8 qf[4];
#pragma unroll
    for (int ks = 0; ks < 4; ++ks) qf[ks] = *(const LAS bf16x8*)(F.lds + R3_Q + (16 * rb + r16) * 272 + (32 * ks + 8 * g) * 2);
#pragma unroll
    for (int t = 0; t < 2; ++t) { const int cb = 2 * hw + t;
        f32x4 acc = {0.f, 0.f, 0.f, 0.f};
#pragma unroll
        for (int ks = 0; ks < 4; ++ks) { const bf16x8 kf = *(const LAS bf16x8*)(F.lds + R3_K + (16 * cb + r16) * 272 + (32 * ks + 8 * g) * 2); acc = MFMA16(qf[ks], kf, acc); }
        const int j = 16 * cb + r16;
#pragma unroll
        for (int r = 0; r < 4; ++r) { const int i = 16 * rb + 4 * g + r; const float v = (i >= j) ? acc[r] * fexp2(lg * (float)(i - j)) : 0.f;
            lds_st16(F.lds + R3_ATT + i * 144 + j * 2, v); }
    }
    f32x4 oa[4];
#pragma unroll
    for (int t = 0; t < 4; ++t) { const int et = 4 * hw + t; f32x4 acc = {0.f, 0.f, 0.f, 0.f};
#pragma unroll
        for (int ks = 0; ks < 4; ++ks) { const bf16x8 sf = *(const LAS bf16x8*)(F.lds + R3_ST + (16 * et + r16) * 272 + (32 * ks + 8 * g) * 2); acc = MFMA16(qf[ks], sf, acc); }
#pragma unroll
        for (int r = 0; r < 4; ++r) acc[r] *= fexp2(lg * (float)(16 * rb + 4 * g + r + 1));
        oa[t] = acc; }
    __syncthreads();
    bf16x8 af[2];
#pragma unroll
    for (int ks = 0; ks < 2; ++ks) af[ks] = *(const LAS bf16x8*)(F.lds + R3_ATT + (16 * rb + r16) * 144 + (32 * ks + 8 * g) * 2);
#pragma unroll
    for (int t = 0; t < 4; ++t) { const int et = 4 * hw + t;
#pragma unroll
        for (int ks = 0; ks < 2; ++ks) { const bf16x8 vf = *(const LAS bf16x8*)(F.lds + R3_VT + (16 * et + r16) * 144 + (32 * ks + 8 * g) * 2); oa[t] = MFMA16(af[ks], vf, oa[t]); }
#pragma unroll
        for (int r = 0; r < 4; ++r) *((LAS float*)(F.lds + R3_OF) + (16 * rb + 4 * g + r) * 132 + 16 * et + r16) = oa[t][r]; }
    __syncthreads();
    ret_norm_store(F, a, l, h, row0, 64, R3_OF);
}

constexpr int RS_S0 = 0, RS_Q = 65536, RS_K = 73728, RS_V = 81920, RS_ATT = 90112, RS_OF = 91136;
DI void rets_task(Frame& F, const Args& a, int l, int unit) {
    const bf16* PROJ = (const bf16*)(F.ws + WS_G);
    const float* rc = (const float*)(F.ws + WS_ROPE); const float* rs = rc + 4096 * 64;
    const int b = unit >> 2, h = unit & 3, row0 = MP + b * 16;
    const float lg = gamma_log2(h);
    const float* s0g = inp(F, I_SRET) + (((size_t)l * 16 + b) * 4 + h) * 16384;
    LAS float* S0 = (LAS float*)(F.lds + RS_S0); LAS float* Q = (LAS float*)(F.lds + RS_Q); LAS float* K = (LAS float*)(F.lds + RS_K); LAS float* V = (LAS float*)(F.lds + RS_V);
    LAS float* ATT = (LAS float*)(F.lds + RS_ATT); LAS float* OF = (LAS float*)(F.lds + RS_OF);
#pragma unroll
    for (int i = 0; i < 8; ++i) { const int id = F.tid + 512 * i; *(LAS f32x4*)(S0 + 4 * id) = *(const f32x4*)(s0g + 4 * id); }
    if (F.tid < 128) { const int tok = F.tid >> 3, cp = F.tid & 7; float o1[8], o2[8];
        rope8(PROJ + (size_t)(row0 + tok) * NIN + C_RQ + h * 128, cp, rc, rs, PAST + tok, o1, o2);
#pragma unroll
        for (int j = 0; j < 8; ++j) { Q[tok * 128 + 8 * cp + j] = o1[j]; Q[tok * 128 + 64 + 8 * cp + j] = o2[j]; }
        rope8(PROJ + (size_t)(row0 + tok) * NIN + C_RK + h * 128, cp, rc, rs, PAST + tok, o1, o2);
#pragma unroll
        for (int j = 0; j < 8; ++j) { K[tok * 128 + 8 * cp + j] = o1[j] * 0.08838834764831845f; K[tok * 128 + 64 + 8 * cp + j] = o2[j] * 0.08838834764831845f; } }
    { const int tok = F.tid >> 5, c4 = F.tid & 31; const u32x2 v = *(const u32x2*)(PROJ + (size_t)(row0 + tok) * NIN + C_RV + h * 128 + 4 * c4);
      V[tok * 128 + 4 * c4] = bf_lo(v.x); V[tok * 128 + 4 * c4 + 1] = bf_hi(v.x); V[tok * 128 + 4 * c4 + 2] = bf_lo(v.y); V[tok * 128 + 4 * c4 + 3] = bf_hi(v.y); }
    __syncthreads();
    if (F.tid < 256) { const int i = F.tid >> 4, j = F.tid & 15; float s = 0.f;
        for (int d = 0; d < 128; ++d) s += Q[i * 128 + d] * K[j * 128 + d];
        ATT[i * 16 + j] = (i >= j) ? s * fexp2(lg * (float)(i - j)) : 0.f; }
    __syncthreads();
    {
        const int e = F.tid & 127, i0 = 4 * (F.tid >> 7);
        float o[4] = {0.f, 0.f, 0.f, 0.f};
        for (int d = 0; d < 128; ++d) { const float s = S0[d * 128 + e];
#pragma unroll
            for (int k = 0; k < 4; ++k) o[k] += Q[(i0 + k) * 128 + d] * s; }
#pragma unroll
        for (int k = 0; k < 4; ++k) { o[k] *= fexp2(lg * (float)(i0 + k + 1));
            for (int j = 0; j <= i0 + k; ++j) o[k] += ATT[(i0 + k) * 16 + j] * V[j * 128 + e];
            OF[(i0 + k) * 132 + e] = o[k]; }
        float* so = F.out + O_RETS + (((size_t)l * 16 + b) * 4 + h) * 16384;
        const float g16 = fexp2(lg * 16.f);
        float vv[16];
#pragma unroll
        for (int j = 0; j < 16; ++j) vv[j] = V[j * 128 + e] * fexp2(lg * (float)(15 - j));
        for (int dd = 0; dd < 32; ++dd) { const int d = 32 * (F.tid >> 7) + dd; float s = S0[d * 128 + e] * g16;
#pragma unroll
            for (int j = 0; j < 16; ++j) s += K[j * 128 + d] * vv[j];
            so[d * 128 + e] = s; }
    }
    __syncthreads();
    ret_norm_store(F, a, l, h, row0, 16, RS_OF);
}

constexpr int AT_KT = 0, AT_VT = 34816, AT_OXW = 16896;
struct AttnCfg {
    int nqt, nmap, nsplit;
    int nq;
    const bf16* qbase; int ldq;
    int qcol0, qcol1;
    int kcol0, kcol1;
    float qscale;
    int nkeys;
    const float* kf; const float* vf; int ldf; int nf32;
    const bf16* kb; const bf16* vb; int ldb;
    const bf16* vt; int ldvt;
    int qpos0;
    int bias;
    int chunkmask;
};
DI void attn_stage(Frame& F, const AttnCfg& C, int st) {
#pragma unroll
    for (int i = 0; i < 4; ++i) {
        const int id = F.tid + 512 * i, row = id >> 4, ch = id & 15, key = st * 128 + row;
        u32x4 kw = {0u, 0u, 0u, 0u}, vw = {0u, 0u, 0u, 0u};
        if (key < C.nf32) {
            const float* kp = C.kf + (size_t)key * C.ldf + 8 * ch; const float* vp = C.vf + (size_t)key * C.ldf + 8 * ch;
            const f32x4 k0 = *(const f32x4*)kp, k1 = *(const f32x4*)(kp + 4), v0 = *(const f32x4*)vp, v1 = *(const f32x4*)(vp + 4);
            kw.x = pk2(k0.x, k0.y); kw.y = pk2(k0.z, k0.w); kw.z = pk2(k1.x, k1.y); kw.w = pk2(k1.z, k1.w);
            vw.x = pk2(v0.x, v0.y); vw.y = pk2(v0.z, v0.w); vw.z = pk2(v1.x, v1.y); vw.w = pk2(v1.z, v1.w);
        } else if (key < C.nkeys) {
            kw = *(const u32x4*)(C.kb + (size_t)(key - C.nf32) * C.ldb + 8 * ch); vw = *(const u32x4*)(C.vb + (size_t)(key - C.nf32) * C.ldb + 8 * ch);
        }
        *(LAS u32x4*)(F.lds + AT_KT + row * 272 + 16 * ch) = kw;
        const unsigned w[4] = {vw.x, vw.y, vw.z, vw.w};
#pragma unroll
        for (int j = 0; j < 4; ++j) { *(LAS unsigned short*)(F.lds + AT_VT + (8 * ch + 2 * j) * 264 + row * 2) = (unsigned short)(w[j] & 0xffffu);
                                      *(LAS unsigned short*)(F.lds + AT_VT + (8 * ch + 2 * j + 1) * 264 + row * 2) = (unsigned short)(w[j] >> 16); }
    }
}

constexpr int AT_BUF = 69632;
template <int KS, bool PF>
DI void attn_run(Frame& F, const AttnCfg& C) {
    const int w = F.wave, r = F.lane & 31, hh = F.lane >> 5;
    const int per_qt = C.nmap * C.nsplit, qt = w / per_qt, rem = w - qt * per_qt, split = rem / C.nmap, map = rem - split * C.nmap;
    const bool active = qt < C.nqt;
    const int kcolm = map ? C.kcol1 : C.kcol0;
    bf16x8 qf[KS];
    {
        const int qr = qt * 32 + (r < C.nq ? r : C.nq - 1);
        const bf16* qp = C.qbase + (size_t)(active ? qr : 0) * C.ldq + (map ? C.qcol1 : C.qcol0) + 8 * hh;
#pragma unroll
        for (int ks = 0; ks < KS; ++ks) { float v[8]; unpack8(*(const u32x4*)(qp + 16 * ks), v);
#pragma unroll
            for (int j = 0; j < 8; ++j) v[j] *= C.qscale;
            qf[ks] = __builtin_bit_cast(bf16x8, pack8(v)); }
    }
    f32x16 o[4];
#pragma unroll
    for (int et = 0; et < 4; ++et)
#pragma unroll
        for (int i = 0; i < 16; ++i) o[et][i] = 0.f;
    float m = 0.f, lsum = 0.f; bool first = true;
    const int qpos_t = C.qpos0 + 32 * qt;
    const int klim = C.chunkmask ? 64 * ((qpos_t >> 6) + 1) : C.nkeys;
    const int nst = (C.nkeys + 127) >> 7;
    const LAS float* TB = (const LAS float*)(F.aux + AUX_BIAS);
#define AT_DMA(st_, bo_) do { _Pragma("unroll") for (int j = 0; j < 5; ++j) { const int blk = w + 8 * j; if (blk < 34) { const int c = blk * 64 + F.lane, row = c / 17, cc = c - row * 17, cq = cc < 16 ? cc : 15; \
        __builtin_amdgcn_global_load_lds((const unsigned*)(C.kb + (size_t)((st_) * 128 + row) * C.ldb + 8 * cq), (LAS unsigned*)(F.lds + (bo_) + AT_KT + blk * 1024), 16, 0, 0); \
        __builtin_amdgcn_global_load_lds((const unsigned*)(C.vt + (size_t)row * C.ldvt + (st_) * 128 + 8 * cq), (LAS unsigned*)(F.lds + (bo_) + AT_KT + 34816 + blk * 1024), 16, 0, 0); } } } while (0)
    if (PF) { __syncthreads(); AT_DMA(0, 0); VM_WAIT(); __syncthreads(); }
    for (int st = 0; st < nst; ++st) {
        const int bo = PF ? (st & 1) * AT_BUF : 0;
        if (!PF) { __syncthreads(); attn_stage(F, C, st); __syncthreads(); }
        else if (st + 1 < nst) AT_DMA(st + 1, ((st + 1) & 1) * AT_BUF);
        if (active) {
#pragma unroll 1
        for (int sb = 0; sb < 4; ++sb) {
            if (C.nsplit > 1 && sb != split) continue;
            const int kg = st * 128 + sb * 32;
            if (kg >= klim) continue;
            const bool fastb = C.bias && (kg + 31 - qpos_t <= -128);
            const float s0 = (fastb ? TB[0] : 0.f) - m;
            bf16x8 kfr[KS];
#pragma unroll
            for (int ks = 0; ks < KS; ++ks) kfr[ks] = *(const LAS bf16x8*)(F.lds + bo + AT_KT + (sb * 32 + r) * 272 + (kcolm + 16 * ks + 8 * hh) * 2);
            f32x16 s;
#pragma unroll
            for (int i = 0; i < 16; ++i) s[i] = s0;
#pragma unroll
            for (int ks = 0; ks < KS; ++ks) s = MFMA32(kfr[ks], qf[ks], s);
            u32x2 vlo[2][2], vhi[2][2];
#pragma unroll
            for (int et = 0; et < 2; ++et)
#pragma unroll
                for (int s2 = 0; s2 < 2; ++s2) { const LAS unsigned char* vp = F.lds + bo + AT_VT + (32 * et + r) * (PF ? 272 : 264) + (sb * 32 + 16 * s2 + 4 * hh) * 2;
                    vlo[et][s2] = *(const LAS u32x2*)vp; vhi[et][s2] = *(const LAS u32x2*)(vp + 16); }
            if (C.bias && !fastb) {
#pragma unroll
                for (int i = 0; i < 16; ++i) { const int key = kg + (i & 3) + 8 * (i >> 2) + 4 * hh; int idx = key - (qpos_t + r) + 128; idx = idx < 0 ? 0 : (idx > 191 ? 191 : idx); s[i] += TB[idx]; }
            }
            if (kg + 32 > C.nkeys) {
#pragma unroll
                for (int i = 0; i < 16; ++i) { const int key = kg + (i & 3) + 8 * (i >> 2) + 4 * hh; if (key >= C.nkeys) s[i] = -1e30f; }
            }
            float mx = s[0];
#pragma unroll
            for (int i = 1; i < 16; ++i) mx = fmaxf(mx, s[i]);
            { auto rr = __builtin_amdgcn_permlane32_swap(__float_as_uint(mx), __float_as_uint(mx), false, false); mx = fmaxf(__uint_as_float(rr[0]), __uint_as_float(rr[1])); }
            if (first || __any(mx > 8.0f)) {
                const float dl = first ? mx : fmaxf(mx, 0.f), al = fexp2(-dl); m += dl; lsum *= al;
#pragma unroll
                for (int i = 0; i < 16; ++i) s[i] -= dl;
#pragma unroll
                for (int et = 0; et < 4; ++et)
#pragma unroll
                    for (int i = 0; i < 16; ++i) o[et][i] *= al;
                first = false; }
            float p[16]; float ps = 0.f;
#pragma unroll
            for (int i = 0; i < 16; ++i) { p[i] = fexp2(s[i]); ps += p[i]; }
            lsum += ps;
            bf16x8 pf[2];
            pf[0] = __builtin_bit_cast(bf16x8, pack8(p)); pf[1] = __builtin_bit_cast(bf16x8, pack8(p + 8));
            u32x2 wlo[2][2], whi[2][2];
#pragma unroll
            for (int et = 0; et < 2; ++et)
#pragma unroll
                for (int s2 = 0; s2 < 2; ++s2) { const LAS unsigned char* vp = F.lds + bo + AT_VT + (32 * (et + 2) + r) * (PF ? 272 : 264) + (sb * 32 + 16 * s2 + 4 * hh) * 2;
                    wlo[et][s2] = *(const LAS u32x2*)vp; whi[et][s2] = *(const LAS u32x2*)(vp + 16); }
#pragma unroll
            for (int et = 0; et < 2; ++et)
#pragma unroll
                for (int s2 = 0; s2 < 2; ++s2) {
                    const u32x4 vv = {vlo[et][s2].x, vlo[et][s2].y, vhi[et][s2].x, vhi[et][s2].y};
                    o[et] = MFMA32(__builtin_bit_cast(bf16x8, vv), pf[s2], o[et]);
                }
#pragma unroll
            for (int et = 0; et < 2; ++et)
#pragma unroll
                for (int s2 = 0; s2 < 2; ++s2) {
                    const u32x4 vv = {wlo[et][s2].x, wlo[et][s2].y, whi[et][s2].x, whi[et][s2].y};
                    o[et + 2] = MFMA32(__builtin_bit_cast(bf16x8, vv), pf[s2], o[et + 2]);
                }
        }
        }
        if (PF) { VM_WAIT(); __syncthreads(); }
    }
#undef AT_DMA
    if (!PF) __syncthreads();
    { auto rr = __builtin_amdgcn_permlane32_swap(__float_as_uint(lsum), __float_as_uint(lsum), false, false); lsum = __uint_as_float(rr[0]) + __uint_as_float(rr[1]); }
    LAS float* OX = (LAS float*)(F.lds + w * AT_OXW);
#pragma unroll
    for (int et = 0; et < 4; ++et)
#pragma unroll
        for (int i = 0; i < 16; ++i) OX[(32 * et + (i & 3) + 8 * (i >> 2) + 4 * hh) * 33 + r] = o[et][i];
    if (hh == 0) { LAS float* ML = (LAS float*)(F.aux + AUX_ML) + (w * 32 + r) * 2; ML[0] = m; ML[1] = lsum; }
    __syncthreads();
}
DI void attn_combine(Frame& F, const AttnCfg& C, int qt, int rq, int map, float& v0, float& v1) {
    const LAS float* MLb = (const LAS float*)(F.aux + AUX_ML);
    const int per_qt = C.nmap * C.nsplit;
    float mstar = -1e30f;
    for (int sp = 0; sp < C.nsplit; ++sp) { const int ww = qt * per_qt + sp * C.nmap + map; mstar = fmaxf(mstar, MLb[(ww * 32 + rq) * 2]); }
    float L = 0.f, a0 = 0.f, a1 = 0.f;
    for (int sp = 0; sp < C.nsplit; ++sp) { const int ww = qt * per_qt + sp * C.nmap + map; const float wgt = fexp2(MLb[(ww * 32 + rq) * 2] - mstar);
        L += wgt * MLb[(ww * 32 + rq) * 2 + 1];
        const LAS float* OX = (const LAS float*)(F.lds + ww * AT_OXW);
        a0 += wgt * OX[(2 * F.lane) * 33 + rq]; a1 += wgt * OX[(2 * F.lane + 1) * 33 + rq]; }
    const float inv = 1.f / L; v0 = a0 * inv; v1 = a1 * inv;
}

DI void fill_bias_table(Frame& F, const Args& a, int h) {
    if (F.tid < 192) { const int rel = F.tid - 128, n = rel < 0 ? -rel : rel;
        int bk = n < 8 ? n : (n < 12 ? 8 : n < 16 ? 9 : n < 23 ? 10 : n < 32 ? 11 : n < 46 ? 12 : n < 64 ? 13 : n < 91 ? 14 : 15);
        if (rel > 0) bk += 16;
        ((LAS float*)(F.aux + AUX_BIAS))[F.tid] = inp(F, I_RELB)[bk * 4 + h] * LOG2E; }
}
DI void diff_lambda(const Frame& F, int l, float& lam, float& one_minus_init) {
    const float* lp = inp(F, I_DLAM) + (size_t)l * 256; float s1 = 0.f, s2 = 0.f;
    for (int i = 0; i < 64; ++i) { s1 += lp[i] * lp[64 + i]; s2 += lp[128 + i] * lp[192 + i]; }
    const float li = (l == 0) ? 0.2f : 0.35550906758730926f;
    lam = expf(s1) - expf(s2) + li; one_minus_init = 1.f - li;
}
DI void diff_finish(Frame& F, const Args& a, const AttnCfg& C, int l, int h, size_t yrow0, int nq_total) {
    const float lam = F.lam, omi = F.omi;
    bf16* Y = (bf16*)(F.ws + WS_Y);
    const float g0 = inp(F, I_DSUB)[(size_t)l * 128 + 2 * F.lane], g1 = inp(F, I_DSUB)[(size_t)l * 128 + 2 * F.lane + 1];
    for (int q = F.wave; q < nq_total; q += 8) {
        const int qt = q >> 5, rq = q & 31;
        float a0, a1, b0, b1; attn_combine(F, C, qt, rq, 0, a0, a1); attn_combine(F, C, qt, rq, 1, b0, b1);
        const float x0 = a0 - lam * b0, x1 = a1 - lam * b1;
        const float ss = wave_sum(x0 * x0 + x1 * x1);
        const float rn = 1.f / sqrtf(ss * (1.f / 128.f) + LN_EPS) * omi;
        *(unsigned*)(Y + (yrow0 + q) * D + 1024 + h * 128 + 2 * F.lane) = pk2(x0 * rn * g0, x1 * rn * g1);
    }
}
DI void mem_finish(Frame& F, const Args& a, const AttnCfg& C, int h, size_t yrow0, int nq_total) {
    bf16* Y = (bf16*)(F.ws + WS_Y);
    for (int q = F.wave; q < nq_total; q += 8) {
        const int qt = q >> 5, rq = q & 31; float a0, a1; attn_combine(F, C, qt, rq, 0, a0, a1);
        *(unsigned*)(Y + (yrow0 + q) * D + 1536 + h * 128 + 2 * F.lane) = pk2(a0, a1);
    }
}


DI void vtrans_task(Frame& F, int task) {
    const bf16* PROJ = (const bf16*)(F.ws + WS_G); bf16* VT = (bf16*)(F.ws + WS_VT);
    const int bh = task >> 4, kb = task & 15, b = bh >> 2, h = bh & 3;
#pragma unroll
    for (int i = 0; i < 8; ++i) { const int id = F.tid + 512 * i, key = id >> 4, ch = id & 15;
        const u32x4 v = *(const u32x4*)(PROJ + (size_t)(b * SEQ + kb * 256 + key) * NIN + C_DV + h * 128 + 8 * ch);
        const unsigned w[4] = {v.x, v.y, v.z, v.w};
#pragma unroll
        for (int j = 0; j < 4; ++j) { *(LAS unsigned short*)(F.lds + (8 * ch + 2 * j) * 528 + key * 2) = (unsigned short)(w[j] & 0xffffu);
                                      *(LAS unsigned short*)(F.lds + (8 * ch + 2 * j + 1) * 528 + key * 2) = (unsigned short)(w[j] >> 16); } }
    __syncthreads();
#pragma unroll
    for (int i = 0; i < 8; ++i) { const int id = F.tid + 512 * i, e = id >> 5, c32 = id & 31;
        *(u32x4*)(VT + ((size_t)(bh * 128 + e)) * 4096 + kb * 256 + 8 * c32) = *(const LAS u32x4*)(F.lds + e * 528 + 16 * c32); }
}

DI void diffp_task(Frame& F, const Args& a, int l, int task) {
    const bf16* PROJ = (const bf16*)(F.ws + WS_G);
    const int qb = 31 - (task >> 4), bh = task & 15, b = bh >> 2, h = bh & 3;
    __syncthreads(); fill_bias_table(F, a, h);
    AttnCfg C; C.nqt = 4; C.nmap = 2; C.nsplit = 1; C.nq = 32;
    C.qbase = PROJ + (size_t)(b * SEQ + qb * 128) * NIN; C.ldq = NIN; C.qcol0 = C_DQ + h * 128; C.qcol1 = C_DQ + h * 128 + 64; C.kcol0 = 0; C.kcol1 = 64;
    C.qscale = 0.125f * LOG2E; C.nkeys = 128 * (qb + 1); C.kf = nullptr; C.vf = nullptr; C.ldf = 0; C.nf32 = 0;
    C.kb = PROJ + (size_t)(b * SEQ) * NIN + C_DK + h * 128; C.vb = PROJ + (size_t)(b * SEQ) * NIN + C_DV + h * 128; C.ldb = NIN;
    C.qpos0 = qb * 128; C.bias = 1; C.chunkmask = 1;
    C.vt = (const bf16*)(F.ws + WS_VT) + (size_t)(bh * 128) * 4096; C.ldvt = 4096;
    attn_run<4, true>(F, C);
    diff_finish(F, a, C, l, h, (size_t)b * SEQ + qb * 128, 128);
}
DI void diffs_task(Frame& F, const Args& a, int l, int task) {
    const bf16* PROJ = (const bf16*)(F.ws + WS_G);
    const int b = task >> 2, h = task & 3;
    __syncthreads(); fill_bias_table(F, a, h);
    AttnCfg C; C.nqt = 1; C.nmap = 2; C.nsplit = 4; C.nq = 16;
    C.qbase = PROJ + (size_t)(MP + b * 16) * NIN; C.ldq = NIN; C.qcol0 = C_DQ + h * 128; C.qcol1 = C_DQ + h * 128 + 64; C.kcol0 = 0; C.kcol1 = 64;
    C.qscale = 0.125f * LOG2E; C.nkeys = PAST + DSEQ;
    C.kf = inp(F, I_CDK) + (((size_t)l * 16 + b) * PAST * 4 + h) * 128; C.vf = inp(F, I_CDV) + (((size_t)l * 16 + b) * PAST * 4 + h) * 128; C.ldf = 512; C.nf32 = PAST;
    C.kb = PROJ + (size_t)(MP + b * 16) * NIN + C_DK + h * 128; C.vb = PROJ + (size_t)(MP + b * 16) * NIN + C_DV + h * 128; C.ldb = NIN;
    C.qpos0 = PAST; C.bias = 1; C.chunkmask = 0;
    C.vt = nullptr; C.ldvt = 0;
    attn_run<4, false>(F, C);
    diff_finish(F, a, C, l, h, (size_t)MP + b * 16, 16);
}
DI void memp_task(Frame& F, const Args& a, int l, int task) {
    const bf16* PROJ = (const bf16*)(F.ws + WS_G); const bf16* MKV = (const bf16*)(F.ws + WS_MEMKV);
    const int qb = task >> 4, bh = task & 15, b = bh >> 2, h = bh & 3;
    AttnCfg C; C.nqt = 8; C.nmap = 1; C.nsplit = 1; C.nq = 32;
    C.qbase = PROJ + (size_t)(b * SEQ + qb * 256) * NIN; C.ldq = NIN; C.qcol0 = C_MQ + h * 128; C.qcol1 = 0; C.kcol0 = 0; C.kcol1 = 0;
    C.qscale = 0.08838834764831845f * LOG2E; C.nkeys = 256; C.kf = nullptr; C.vf = nullptr; C.ldf = 0; C.nf32 = 0;
    C.kb = MKV + (size_t)(b * 256) * 1024 + h * 128; C.vb = MKV + (size_t)(b * 256) * 1024 + 512 + h * 128; C.ldb = 1024;
    C.qpos0 = 0; C.bias = 0; C.chunkmask = 0;
    C.vt = nullptr; C.ldvt = 0;
    attn_run<8, false>(F, C);
    mem_finish(F, a, C, h, (size_t)b * SEQ + qb * 256, 256);
}
DI void mems_task(Frame& F, const Args& a, int l, int task) {
    const bf16* PROJ = (const bf16*)(F.ws + WS_G);
    const int b = task >> 2, h = task & 3;
    AttnCfg C; C.nqt = 1; C.nmap = 1; C.nsplit = 4; C.nq = 16;
    C.qbase = PROJ + (size_t)(MP + b * 16) * NIN; C.ldq = NIN; C.qcol0 = C_MQ + h * 128; C.qcol1 = 0; C.kcol0 = 0; C.kcol1 = 0;
    C.qscale = 0.08838834764831845f * LOG2E; C.nkeys = 256;
    C.kf = inp(F, I_CMK) + (((size_t)l * 16 + b) * 256 * 4 + h) * 128; C.vf = inp(F, I_CMV) + (((size_t)l * 16 + b) * 256 * 4 + h) * 128; C.ldf = 512; C.nf32 = 256;
    C.kb = nullptr; C.vb = nullptr; C.ldb = 0; C.qpos0 = 0; C.bias = 0; C.chunkmask = 0;
    C.vt = nullptr; C.ldvt = 0;
    attn_run<8, false>(F, C);
    mem_finish(F, a, C, h, (size_t)MP + b * 16, 16);
}

#ifndef PROBE_REPS
#define PROBE_REPS {1,1,1,1,1,1,1,1,1,1,1,1,1,1}
#endif
constexpr int REPS[14] = PROBE_REPS;
#ifndef PROBE_SUBREP
#define PROBE_SUBREP {1,1,1}
#endif
constexpr int SUBREP[3] = PROBE_SUBREP;
#define FRESH() do { int t_ = threadIdx.x; asm volatile("" : "+v"(t_)); F.tid = t_; F.lane = t_ & 63; F.wave = __builtin_amdgcn_readfirstlane(t_ >> 6); { unsigned long long wsi_ = (unsigned long long)args.ws; asm volatile("" : "+s"(wsi_)); ws = (unsigned char*)(GAS unsigned char*)wsi_; } F.ws = ws; F.out = (float*)inp(F, 30); \
    XB = (bf16*)(ws + WS_XB); Gb = (bf16*)(ws + WS_G); GATE = (bf16*)(ws + WS_GATE); Yb = (bf16*)(ws + WS_Y); wl = ws + WS_W + (size_t)l * LAYER_W; } while (0)
#define SEAM() do { XcdBarrier b_ = bar; unsigned long long bi_ = (unsigned long long)b_.bar; asm volatile("" : "+s"(bi_)); b_.bar = (unsigned*)(GAS unsigned*)bi_; xcd_barrier(b_); } while (0)
#define PHASE_LOCALS unsigned char* ws; bf16* XB; bf16* Gb; bf16* GATE; bf16* Yb; unsigned char* wl; const int nMall = M / 256; (void)Yb; (void)nMall; (void)XB; (void)Gb; (void)GATE; (void)wl

DI void ffn_half(Frame& F, const Args& args, const XcdBarrier& bar, const int l, const int half) {
    PHASE_LOCALS;
    for (int rep = 0; rep < REPS[1]; ++rep) { if (rep) SEAM(); FRESH();
        { pg8::Gemm g{XB, (const bf16*)(wl + (half ? W_UP2 : W_UP1)), D, D, D / 64, 128, 256 * D * 2}; pg8::StaticOrder S; S.init(MP / 256, NUP / 256, F.G, F.bid);
          pg8::EpiSwiglu E{Gb}; pg8::gemm_phase<pg8::EpiSwiglu, pg8::StaticOrder, true>(F.lds, F.tid, g, S, E); }
        { pg8::Gemm g{XB, (const bf16*)(wl + (half ? W_UP2 : W_UP1)), D, D, D / 64, 128, 256 * D * 2}; pg8::StaticOrder S; S.init_splitk(1, NUP / 256, F.G, F.G - 1 - F.bid, 0, MP / 256);
          pg8::EpiSwiglu E{Gb}; pg8::gemm_phase<pg8::EpiSwiglu, pg8::StaticOrder, true>(F.lds, F.tid, g, S, E); } }
    SEAM();
    { FRESH();
        { pg8::Gemm g{Gb, (const bf16*)(wl + (half ? W_DN2 : W_DN1)), 64, FF, FF / 64, 32768, (FF / 64) * 32768}; pg8::StaticOrder S; S.init(MP / 256, D / 256, F.G, F.bid, 1, 0, 4);
          pg8::EpiY E{GATE}; pg8::gemm_phase<pg8::EpiY, pg8::StaticOrder, true>(F.lds, F.tid, g, S, E); }
        { pg8::Gemm g{Gb, (const bf16*)(wl + (half ? W_DN2 : W_DN1)), 64, FF, 8, 32768, (FF / 64) * 32768}; pg8::StaticOrder S; S.init_splitk(11, D / 256, F.G, F.G - 1 - F.bid, 512, MP / 256);
          pg8::EpiSlab E{(float*)(ws + WS_SLAB)}; pg8::gemm_phase<pg8::EpiSlab, pg8::StaticOrder, true>(F.lds, F.tid, g, S, E); } }
    SEAM();
    { FRESH();
        const float* lg = inp(F, half ? I_LN3G : I_LN1G) + (size_t)l * D; const float* lb = inp(F, half ? I_LN3B : I_LN1B) + (size_t)l * D;
        const bool fin = (l == 1 && half == 1);
        if (l == 0 && half == 0) ln_phase<true>(F, inp(F, I_XP), inp(F, I_XS), GATE, nullptr, nullptr, XB, lg, lb, (const float*)(ws + WS_SLAB), 11, 0.5f);
        else ln_phase<false>(F, XB, XB + (size_t)MP * D, GATE, fin ? F.out + O_YP : nullptr, fin ? F.out + O_YS : nullptr, fin ? nullptr : XB, lg, lb, (const float*)(ws + WS_SLAB), 11, 0.5f); }
}
DI void mixer_block(Frame& F, const Args& args, const XcdBarrier& bar, const int l) {
    PHASE_LOCALS;
    for (int rep = 0; rep < REPS[4]; ++rep) { if (rep) SEAM(); FRESH();
        { pg8::Gemm g{XB, (const bf16*)(wl + W_IG), D, D, D / 64, 128, 256 * D * 2}; pg8::StaticOrder S; S.init(MP / 256, NIG / 256, F.G, F.bid);
          pg8::EpiInGate E{Gb, GATE, inp(F, I_BGATE) + (size_t)l * NGATE, F.out + O_DKP + (size_t)l * MP * 512, F.out + O_DVP + (size_t)l * MP * 512,
                           F.out + O_DKS + (size_t)l * MS * 512, F.out + O_DVS + (size_t)l * MS * 512};
          pg8::gemm_phase<pg8::EpiInGate, pg8::StaticOrder, true>(F.lds, F.tid, g, S, E); }
        { pg8::Gemm g{XB, (const bf16*)(wl + W_IG), D, D, D / 64, 128, 256 * D * 2}; pg8::StaticOrder S; S.init_splitk(1, NIG / 256, F.G, F.G - 1 - F.bid, 0, MP / 256);
          pg8::EpiInGate E{Gb, GATE, inp(F, I_BGATE) + (size_t)l * NGATE, F.out + O_DKP + (size_t)l * MP * 512, F.out + O_DVP + (size_t)l * MP * 512,
                           F.out + O_DKS + (size_t)l * MS * 512, F.out + O_DVS + (size_t)l * MS * 512};
          pg8::gemm_phase<pg8::EpiInGate, pg8::StaticOrder, true>(F.lds, F.tid, g, S, E); }
        { pg8::Gemm g{(const bf16*)(ws + WS_MEMX), (const bf16*)(wl + W_MKV), D, D, D / 64, 128, 256 * D * 2}; pg8::StaticOrder S; S.init(4, 4, F.G, F.G - 1 - 54 - F.bid < 0 ? F.G : F.G - 1 - 54 - F.bid);
          pg8::EpiMemKV E{(bf16*)(ws + WS_MEMKV), F.out + O_MKP + (size_t)l * 1024 * 512, F.out + O_MVP + (size_t)l * 1024 * 512};
          pg8::gemm_phase<pg8::EpiMemKV, pg8::StaticOrder, true>(F.lds, F.tid, g, S, E); }
    }
    SEAM();
    for (int rep = 0; rep < REPS[5]; ++rep) { if (rep) SEAM(); FRESH();
        { const int t = F.bid - (F.G - 64); if (t >= 0 && t < 64) { __syncthreads(); rets_task(F, args, l, t); } }
        { const int t = F.bid - (F.G - 128); if (t >= 0 && t < 64) { __syncthreads(); mems_task(F, args, l, t); } }
        for (int t = F.bid; t < 65; t += F.G) { __syncthreads(); conv_task(F, args, l, t); }
        for (int t = F.bid; t < 1024; t += F.G) { __syncthreads(); ret1_task(F, args, l, t); }
        for (int t = F.bid; t < 256; t += F.G) { __syncthreads(); memp_task(F, args, l, t); }
        for (int t = F.bid; t < 256; t += F.G) { __syncthreads(); vtrans_task(F, t); }
        __syncthreads();
    }
    SEAM();
    for (int rep = 0; rep < REPS[6]; ++rep) { if (rep) SEAM(); FRESH();
        const int q = l * 64 + rep * 16;
        diff_lambda(F, l, F.lam, F.omi);
        for (int sr = 0; sr < SUBREP[0]; ++sr) for (;;) { const int t = wq_next(F, q + 5 + 32 * sr); if (t >= 64) break; diffs_task(F, args, l, t); }
        for (int sr = 0; sr < SUBREP[1]; ++sr) for (;;) { const int t = wq_next(F, q + 6 + 32 * sr); if (t >= 512) break; diffp_task(F, args, l, t); }
        for (int sr = 0; sr < SUBREP[2]; ++sr) for (int t = F.bid; t < 256; t += F.G) { __syncthreads(); ret2_task(F, args, l, t); }
    }
    SEAM();
    for (int rep = 0; rep < REPS[7]; ++rep) { if (rep) SEAM(); FRESH();
        for (int t = F.bid; t < 1024; t += F.G) { __syncthreads(); ret3_task(F, args, l, t); }
        __syncthreads();
    }
    SEAM();
    { FRESH();
        { pg8::Gemm g{Yb, (const bf16*)(wl + W_BR), D, D, 8, 128, 256 * D * 2}; pg8::StaticOrder S; S.init(MP / 256, D / 256, F.G, F.bid, 4, 512);
          pg8::EpiBranch E{GATE, Gb}; pg8::gemm_phase<pg8::EpiBranch, pg8::StaticOrder, true>(F.lds, F.tid, g, S, E); }
        { pg8::Gemm g{Yb, (const bf16*)(wl + W_BR), D, D, 8, 128, 256 * D * 2}; pg8::StaticOrder S; S.init_splitk(4, D / 256, F.G, F.G - 1 - F.bid, 512, MP / 256);
          pg8::EpiBranchS E{GATE, (bf16*)(ws + WS_BRS)}; pg8::gemm_phase<pg8::EpiBranchS, pg8::StaticOrder, true>(F.lds, F.tid, g, S, E); } }
    SEAM();
    { FRESH();
        { pg8::Gemm g{Gb, (const bf16*)(wl + W_WO), D, D, D / 64, 128, 256 * D * 2}; pg8::StaticOrder S; S.init(MP / 256, D / 256, F.G, F.bid);
          pg8::EpiY E{GATE}; pg8::gemm_phase<pg8::EpiY, pg8::StaticOrder, true>(F.lds, F.tid, g, S, E); }
        { pg8::Gemm g{(const bf16*)(ws + WS_BRS), (const bf16*)(wl + W_WO), D, D, 8, 128, 256 * D * 2}; pg8::StaticOrder S; S.init_seg4(4, D / 256, F.G, F.G - 1 - F.bid, 512, 0);
          pg8::EpiSlab E{(float*)(ws + WS_SLAB)}; pg8::gemm_phase<pg8::EpiSlab, pg8::StaticOrder, true>(F.lds, F.tid, g, S, E); } }
    SEAM();
    { FRESH(); ln_phase<false>(F, XB, XB + (size_t)MP * D, GATE, nullptr, nullptr, XB, inp(F, I_LN2G) + (size_t)l * D, inp(F, I_LN2B) + (size_t)l * D, (const float*)(ws + WS_SLAB), 16, 1.0f); }
    SEAM();
}

__global__ void __launch_bounds__(512, 2) fwd_kernel(Args args) {
    extern __shared__ __attribute__((aligned(16))) unsigned char lds_raw[];
    Frame F;
    F.lds = (LAS unsigned char*)lds_raw; F.aux = F.lds + AUX_OFF; F.MISC = (volatile LAS unsigned*)(F.aux + AUX_MISC);
    F.tid = threadIdx.x; F.lane = F.tid & 63; F.wave = __builtin_amdgcn_readfirstlane(F.tid >> 6); F.G = gridDim.x; F.bid = blockIdx.x;
    F.ctl = (gu32*)(args.ws + WS_CTL);
    for (int u = F.tid; u < 64; u += 512) F.MISC[u] = 0u;
    if (F.tid == 0) { LAS unsigned long long* tb = (LAS unsigned long long*)(F.aux + AUX_TBL);
#pragma unroll
        for (int k = 0; k < 30; ++k) tb[k] = (unsigned long long)args.in[k];
        tb[30] = (unsigned long long)args.out; }
    __syncthreads();
    const XcdBarrier bar = xcd_barrier_post((unsigned*)(F.ctl + CW_BAR), F.MISC + 8);
    { PHASE_LOCALS; for (int rep = 0; rep < REPS[0]; ++rep) { if (rep) SEAM(); const int l = 0; FRESH(); p0_prologue(F, args, ws); } SEAM(); }
    ffn_half(F, args, bar, 0, 0); { SEAM(); }
    mixer_block(F, args, bar, 0);
    ffn_half(F, args, bar, 0, 1); { SEAM(); }
    ffn_half(F, args, bar, 1, 0); { SEAM(); }
    mixer_block(F, args, bar, 1);
    ffn_half(F, args, bar, 1, 1);
}
#undef SEAM
#undef FRESH

extern "C" void kernel_launch(void* const* d_in, const int* in_sizes, int n_in, void* d_out, int out_size, void* d_ws, size_t ws_size, hipStream_t stream) {
    static int grid = 0;
    if (grid == 0) {
        if (n_in != 30 || (size_t)out_size != O_END || ws_size < WS_END) { fprintf(stderr, "kernel_launch: unexpected sizes: n_in %d out %d (want %zu) ws %zu (want >= %zu)\n", n_in, out_size, (size_t)O_END, ws_size, (size_t)WS_END); grid = -1; return; }
        int dev = 0, cus = 0, per_cu = 0;
        if (hipGetDevice(&dev) != hipSuccess || hipDeviceGetAttribute(&cus, hipDeviceAttributeMultiprocessorCount, dev) != hipSuccess) { grid = -1; return; }
        if (hipFuncSetAttribute((const void*)fwd_kernel, hipFuncAttributeMaxDynamicSharedMemorySize, LDS_BYTES) != hipSuccess) { fprintf(stderr, "kernel_launch: hipFuncSetAttribute failed\n"); grid = -1; return; }
        if (hipOccupancyMaxActiveBlocksPerMultiprocessor(&per_cu, (const void*)fwd_kernel, 512, LDS_BYTES) != hipSuccess || per_cu < 1) fprintf(stderr, "kernel_launch: occupancy query says %d\n", per_cu);
        (void)hipGetLastError();
        grid = cus;
    }
    if (grid < 0) return;
    (void)hipMemsetAsync((char*)d_ws + WS_CTL, 0, CTL_ZERO_BYTES, stream);
    Args a{};
    for (int i = 0; i < 30; ++i) a.in[i] = (const float*)d_in[i];
    a.out = (float*)d_out; a.ws = (unsigned char*)d_ws;
    a.ph_lo = 0; a.ph_hi = 0;
    hipLaunchKernelGGL(fwd_kernel, dim3(grid), dim3(512), LDS_BYTES, stream, a);
}
```

```cpp
#include <hip/hip_runtime.h>
#include <cstdio>
#include <cstdint>

#define GAS __attribute__((address_space(1)))
#define LAS __attribute__((address_space(3)))
typedef unsigned short bf16;
typedef short bf16x8 __attribute__((ext_vector_type(8)));
typedef float f32x2 __attribute__((ext_vector_type(2)));
typedef float f32x4 __attribute__((ext_vector_type(4)));
typedef float f32x16 __attribute__((ext_vector_type(16)));
typedef unsigned u32x2 __attribute__((ext_vector_type(2)));
typedef unsigned u32x4 __attribute__((ext_vector_type(4)));
typedef __bf16 bf16v2 __attribute__((ext_vector_type(2)));
typedef GAS unsigned gu32;
#define DI __device__ __forceinline__
#define RLX_AGENT __ATOMIC_RELAXED, __HIP_MEMORY_SCOPE_AGENT

constexpr int D = 2048, FF = 5632, NUP = 2 * FF, NIN = 5632, NGATE = 8192, NIG = NIN + NGATE;
constexpr int MP = 16384, MS = 256, M = MP + MS;
constexpr int SEQ = 4096, PAST = 2048, DSEQ = 16;
constexpr int C_CB = 0, C_CC = 512, C_CH = 1024, C_RQ = 1536, C_RK = 2048, C_RV = 2560, C_RG = 3072, C_DQ = 3584, C_DK = 4096, C_DV = 4608, C_MQ = 5120;
constexpr float LN_EPS = 1e-5f;
constexpr float ALPHA = 1.4142135623730951f;
constexpr float LOG2E = 1.4426950408889634f;
constexpr size_t O_YP = 0, O_YS = O_YP + (size_t)MP * D, O_CONVP = O_YS + (size_t)MS * D, O_RETP = O_CONVP + 2 * 4 * 2 * 512,
                 O_DKP = O_RETP + 2 * 4 * 4 * 128 * 128, O_DVP = O_DKP + (size_t)2 * MP * 512, O_MKP = O_DVP + (size_t)2 * MP * 512,
                 O_MVP = O_MKP + 2 * 1024 * 512, O_CONVS = O_MVP + 2 * 1024 * 512, O_RETS = O_CONVS + 2 * 16 * 2 * 512,
                 O_DKS = O_RETS + 2 * 16 * 4 * 128 * 128, O_DVS = O_DKS + 2 * 256 * 512, O_END = O_DVS + 2 * 256 * 512;

constexpr size_t MiB = 1u << 20;
constexpr size_t WS_CTL = 0, CTL_ZERO_BYTES = 1 * MiB;
constexpr size_t WS_ROPE = 1 * MiB;
constexpr size_t WS_MEMX = 3 * MiB;
constexpr size_t WS_MEMKV = 7 * MiB;
constexpr size_t WS_W = 16 * MiB;
constexpr size_t W_UP1 = 0, W_DN1 = W_UP1 + (size_t)NUP * D * 2, W_IG = W_DN1 + (size_t)D * FF * 2, W_MKV = W_IG + (size_t)NIG * D * 2,
                 W_BR = W_MKV + (size_t)1024 * D * 2, W_WO = W_BR + (size_t)D * D * 2, W_UP2 = W_WO + (size_t)D * D * 2, W_DN2 = W_UP2 + (size_t)NUP * D * 2,
                 LAYER_W = W_DN2 + (size_t)D * FF * 2;
constexpr size_t WS_XA = WS_W + 2 * LAYER_W;
constexpr size_t WS_XB = WS_XA + (size_t)M * D * 4;
constexpr size_t WS_G = WS_XB + (size_t)M * D * 2;
constexpr size_t WS_GATE = WS_G + (size_t)M * FF * 2;
constexpr size_t WS_Y = WS_GATE + (size_t)M * NGATE * 2;
constexpr size_t WS_RETS = WS_Y + (size_t)M * D * 2;
constexpr size_t WS_SLAB = WS_RETS + (size_t)1024 * 128 * 128 * 2;
constexpr size_t WS_VT = WS_SLAB + (size_t)16 * 256 * D * 4;
constexpr size_t WS_BRS = WS_VT + (size_t)16 * 128 * 4096 * 2;
constexpr size_t WS_END = WS_BRS + (size_t)4 * 256 * D * 2;
static_assert(LAYER_W == (size_t)216006656, "layer weights");
static_assert((size_t)1024 * 128 * 128 * 4 <= (size_t)M * D * 4, "RETKV fits its region");
constexpr int CW_BAR = 4096;
constexpr int CW_WQ = 16384;

constexpr int LDS_SCRATCH = 139264;
constexpr int AUX_OFF = LDS_SCRATCH;
constexpr int AUX_ML = 0, AUX_BIAS = 2048, AUX_MISC = 3072;
constexpr int LDS_BYTES = 147456;

DI unsigned pk2(float lo, float hi) { f32x2 v = {lo, hi}; return __builtin_bit_cast(unsigned, __builtin_convertvector(v, bf16v2)); }
DI float bf_lo(unsigned u) { return __uint_as_float(u << 16); }
DI float bf_hi(unsigned u) { return __uint_as_float(u & 0xffff0000u); }
DI float bf2f(bf16 b) { return __uint_as_float(((unsigned)b) << 16); }
DI float fexp2(float x) { return __builtin_amdgcn_exp2f(x); }
DI float frcp(float x) { return __builtin_amdgcn_rcpf(x); }
DI float sigmoidf_(float x) { return frcp(1.0f + fexp2(-x * LOG2E)); }
DI float siluf_(float x) { return x * sigmoidf_(x); }
DI u32x4 pack8(const float* v) { u32x4 w; w.x = pk2(v[0], v[1]); w.y = pk2(v[2], v[3]); w.z = pk2(v[4], v[5]); w.w = pk2(v[6], v[7]); return w; }
DI void unpack8(u32x4 w, float* v) { v[0] = bf_lo(w.x); v[1] = bf_hi(w.x); v[2] = bf_lo(w.y); v[3] = bf_hi(w.y); v[4] = bf_lo(w.z); v[5] = bf_hi(w.z); v[6] = bf_lo(w.w); v[7] = bf_hi(w.w); }
DI u32x2 pack8_u8(const float* g) {
    unsigned q[8];
#pragma unroll
    for (int k = 0; k < 8; ++k) q[k] = (unsigned)(g[k] * 255.0f + 0.5f);
    u32x2 w; w.x = q[0] | (q[1] << 8) | (q[2] << 16) | (q[3] << 24); w.y = q[4] | (q[5] << 8) | (q[6] << 16) | (q[7] << 24); return w;
}
DI void unpack8_u8(u32x2 w, float* g) {
    g[0] = (float)(w.x & 0xffu); g[1] = (float)((w.x >> 8) & 0xffu); g[2] = (float)((w.x >> 16) & 0xffu); g[3] = (float)(w.x >> 24);
    g[4] = (float)(w.y & 0xffu); g[5] = (float)((w.y >> 8) & 0xffu); g[6] = (float)((w.y >> 16) & 0xffu); g[7] = (float)(w.y >> 24);
}
DI float wave_sum(float v) {
#pragma unroll
    for (int o = 1; o < 64; o <<= 1) v += __shfl_xor(v, o);
    return v;
}
#define LDS_WAIT() asm volatile("s_waitcnt lgkmcnt(0)" ::: "memory")
#define VM_WAIT() asm volatile("s_waitcnt vmcnt(0)" ::: "memory")

namespace pg8 {
#define PG8_LAS __attribute__((address_space(3)))
typedef unsigned short bf16_t;
constexpr int BM = 256, BK = 64, HALF = 128, HTB = HALF * BK * 2, STAGE_BYTES = 8 * HTB, NXCD = 8, WGM = 8;
__host__ __device__ __forceinline__ int lds_byte(int r, int c) { const int st = (r >> 4) * 2 + (c >> 5), rr = r & 15, cc = c & 31, ob = rr * 64 + cc * 2; return st * 1024 + (ob ^ (((ob >> 9) & 1) << 5)); }
__host__ __device__ __forceinline__ void stage_rc(int b, int& R, int& C) { const int st = b / 1024, sb = b % 1024, swz = sb ^ (((sb >> 9) & 1) << 5); R = (st >> 1) * 16 + swz / 64; C = (st & 1) * 32 + (swz % 64) / 2; }
__host__ __device__ __forceinline__ int perm32(int rho) { const int n = rho >> 4, i = rho & 15; return 8 * (i >> 2) + 4 * n + (i & 3); }

struct Unit { int pm, pn, ko, sub; };
struct Gemm { const bf16_t* A; const bf16_t* Bt; int lda, ldb, nt; int kstepA, tileA;
};

struct StaticOrder {
    int nM, nN, nwg, G, c, nsub, ksub, pmfix, wgm, seg4;
    __device__ void init(int nM_, int nN_, int G_, int c_, int nsub_ = 1, int ksub_ = 0, int wgm_ = WGM) { nM = nM_; nN = nN_; nwg = nM * nN; G = G_; c = c_; nsub = nsub_; ksub = ksub_; pmfix = -1; wgm = wgm_; seg4 = 0; }
    __device__ void init_splitk(int nsplit, int nN_, int G_, int c_, int ksub_, int pmfix_) { nM = nsplit; nN = nN_; nwg = nM * nN; G = G_; c = c_; nsub = 1; ksub = ksub_; pmfix = pmfix_; wgm = WGM; seg4 = 0; }
    __device__ void init_seg4(int npan, int nN_, int G_, int c_, int ksub_, int pmfix_) { init_splitk(4 * npan, nN_, G_, c_, ksub_, pmfix_); seg4 = 1; }
    __device__ bool next(int i, Unit& u) const {
        const int ti = i / nsub, sub = i - ti * nsub;
        const long L = (long)ti * G + c; if (L >= nwg) return false;
        int wgid = (int)L; { const int q = nwg / NXCD, r = nwg % NXCD, xcd = wgid % NXCD, off = wgid / NXCD; wgid = (xcd < r ? xcd * (q + 1) : r * (q + 1) + (xcd - r) * q) + off; }
        const int nig = wgm * nN, gid = wgid / nig, fm = gid * wgm, gsz = (nM - fm) < wgm ? (nM - fm) : wgm;
        u.pm = fm + ((wgid % nig) % gsz); u.pn = (wgid % nig) / gsz; u.ko = sub * ksub; u.sub = sub;
        if (pmfix >= 0) { u.sub = u.pm; if (seg4) { u.ko = (u.pm & 3) * ksub; u.pm = pmfix + (u.pm >> 2); } else { u.ko = u.pm * ksub; u.pm = pmfix; } }
        return true;
    }
};

template <class Epi, class Sched, bool ALIGN_EPI>
__device__ __forceinline__ void gemm_phase(PG8_LAS unsigned char* lds, const int tid, const Gemm g, const Sched& S, const Epi& E) {
    const int wid = __builtin_amdgcn_readfirstlane(tid >> 6), lane = tid & 63, wr = wid >> 2, wc = wid & 3, fr = lane & 15, fq = lane >> 4;
    const int nt = g.nt;
    unsigned voffA, voffB;
    { int R, C; stage_rc(tid * 16, R, C); const int Rb = Epi::PERM ? ((R & ~31) + perm32(R & 31)) : R;
      voffA = (unsigned)(R * g.lda + C) * 2u; voffB = (unsigned)tid * 16u; (void)Rb; }
    const unsigned piece_voffA = 64u * (unsigned)g.lda * 2u, piece_voffB = 8192u;
    const unsigned kstep = 32768u, kstepA = (unsigned)g.kstepA;
    const unsigned hstepA = (unsigned)HALF * (unsigned)g.lda * 2u, hstepB = 16384u, tileB = (unsigned)(g.ldb >> 6) * 32768u;
    const unsigned ldsw = (unsigned)wid * 1024u;
    const int aoff = lds_byte(wr * 64 + fr, fq * 8), boff = lds_byte(wc * 32 + fr, fq * 8);
    const char* const baseA = (const char*)g.A; const char* const baseB = (const char*)g.Bt;
#define PG8_SA(b, h) (((b) * 2 + (h)) * HTB)
#define PG8_SB(b, h) ((4 + (b) * 2 + (h)) * HTB)
#define PG8_STAGE_(bufoff, gbase, goff, voff, piece) do { _Pragma("unroll") for (int _i = 0; _i < 2; ++_i) \
        __builtin_amdgcn_global_load_lds((const unsigned*)((gbase) + (size_t)(unsigned)((goff) + (_i ? (piece) : 0u) + (voff))), (PG8_LAS unsigned*)(lds + (bufoff) + ldsw + _i * 8192), 16, 0, 0); } while (0)
#define PG8_STAGE(bufoff, goff, voff) PG8_STAGE_(bufoff, base_##voff, goff, voff, piece_##voff)
#define base_voffA baseA
#define base_voffB baseB
#define PG8_LDA(dst, b, h) do { _Pragma("unroll") for (int m = 0; m < 4; ++m) _Pragma("unroll") for (int k = 0; k < 2; ++k) dst[m][k] = *(const PG8_LAS bf16x8*)(lds + PG8_SA(b, h) + aoff + m * 2048 + k * 1024); } while (0)
#define PG8_LDB(dst, b, h) do { _Pragma("unroll") for (int n = 0; n < 2; ++n) _Pragma("unroll") for (int k = 0; k < 2; ++k) dst[n][k] = *(const PG8_LAS bf16x8*)(lds + PG8_SB(b, h) + boff + n * 2048 + k * 1024); } while (0)
#define PG8_MMA(ai, bj, At, Bt) do { __builtin_amdgcn_s_setprio(1); _Pragma("unroll") for (int m = 0; m < 4; ++m) _Pragma("unroll") for (int n = 0; n < 2; ++n) _Pragma("unroll") for (int k = 0; k < 2; ++k) \
        acc[ai][bj][m][n] = __builtin_amdgcn_mfma_f32_16x16x32_bf16(Bt[n][k], At[m][k], acc[ai][bj][m][n], 0, 0, 0); __builtin_amdgcn_s_setprio(0); } while (0)
#define PG8_WAIT_V(n) asm volatile("s_waitcnt vmcnt(" #n ")" ::: "memory")
#define PG8_WAIT_L(n) asm volatile("s_waitcnt lgkmcnt(" #n ")" ::: "memory")
#define PG8_BAR __builtin_amdgcn_s_barrier()
#define PG8_SCHED __builtin_amdgcn_sched_barrier(0)
    Unit cur, nxt; int ui = 0;
    if (!S.next(0, cur)) return;
    f32x4 acc[2][2][4][2];
#pragma unroll
    for (int a = 0; a < 2; ++a)
#pragma unroll
        for (int b = 0; b < 2; ++b)
#pragma unroll
            for (int m = 0; m < 4; ++m)
#pragma unroll
                for (int n = 0; n < 2; ++n) acc[a][b][m][n] = (f32x4){0.f, 0.f, 0.f, 0.f};
    bf16x8 At[4][2], B0[2][2], B1[2][2];
    unsigned cA = (unsigned)cur.pm * (unsigned)g.tileA + (unsigned)(cur.ko >> 6) * kstepA, cB = (unsigned)cur.pn * tileB + (unsigned)(cur.ko >> 6) * kstep;
    PG8_STAGE(PG8_SB(0, 0), cB, voffB); PG8_STAGE(PG8_SB(0, 1), cB + hstepB, voffB); PG8_STAGE(PG8_SA(0, 0), cA, voffA); PG8_STAGE(PG8_SA(0, 1), cA + hstepA, voffA);
    if (wr == 1) PG8_BAR;
    PG8_WAIT_V(2); PG8_BAR;
    PG8_STAGE(PG8_SB(1, 0), cB + kstep, voffB); PG8_STAGE(PG8_SA(1, 0), cA + kstepA, voffA); PG8_STAGE(PG8_SB(1, 1), cB + hstepB + kstep, voffB);
    PG8_WAIT_V(6); PG8_BAR;
    for (;;) {
        const bool has_next = S.next(ui + 1, nxt);
        const unsigned nA = has_next ? (unsigned)nxt.pm * (unsigned)g.tileA + (unsigned)(nxt.ko >> 6) * kstepA : cA, nB = has_next ? (unsigned)nxt.pn * tileB + (unsigned)(nxt.ko >> 6) * kstep : cB;
        for (int t = 0; t < nt; t += 2) {
            const bool last = (t == nt - 2);
            const unsigned a1 = cA + (unsigned)(t + 1) * kstepA;
            const unsigned a2 = last ? nA : cA + (unsigned)(t + 2) * kstepA, b2 = last ? nB : cB + (unsigned)(t + 2) * kstep;
            const unsigned a3 = a2 + kstepA, b3 = b2 + kstep;
            PG8_LDB(B0, 0, 0); PG8_LDB(B1, 0, 1); PG8_SCHED; PG8_LDA(At, 0, 0); PG8_STAGE(PG8_SA(1, 1), a1 + hstepA, voffA);
            PG8_WAIT_V(8); PG8_WAIT_L(0); PG8_BAR; PG8_MMA(0, 0, At, B0); PG8_MMA(0, 1, At, B1); PG8_BAR; PG8_SCHED;
            PG8_LDA(At, 0, 1); PG8_STAGE(PG8_SB(0, 0), b2, voffB); PG8_STAGE(PG8_SB(0, 1), b2 + hstepB, voffB); PG8_STAGE(PG8_SA(0, 0), a2, voffA);
            PG8_WAIT_V(8); PG8_WAIT_L(0); PG8_BAR; PG8_MMA(1, 0, At, B0); PG8_MMA(1, 1, At, B1); PG8_BAR; PG8_SCHED;
            PG8_LDB(B0, 1, 0); PG8_LDB(B1, 1, 1); PG8_SCHED; PG8_LDA(At, 1, 0); PG8_STAGE(PG8_SA(0, 1), a2 + hstepA, voffA);
            PG8_WAIT_V(8); PG8_WAIT_L(0); PG8_BAR; PG8_MMA(0, 0, At, B0); PG8_MMA(0, 1, At, B1); PG8_BAR; PG8_SCHED;
            PG8_LDA(At, 1, 1); PG8_STAGE(PG8_SB(1, 0), b3, voffB); PG8_STAGE(PG8_SB(1, 1), b3 + hstepB, voffB); PG8_STAGE(PG8_SA(1, 0), a3, voffA);
            PG8_WAIT_V(8); PG8_WAIT_L(0); PG8_BAR; PG8_MMA(1, 0, At, B0); PG8_MMA(1, 1, At, B1); PG8_BAR; PG8_SCHED;
        }
        if constexpr (ALIGN_EPI) { if (wr == 0) PG8_BAR; }
        E(acc, cur, wr, wc, fr, fq);
        if (!has_next) break;
#pragma unroll
        for (int a = 0; a < 2; ++a)
#pragma unroll
            for (int b = 0; b < 2; ++b)
#pragma unroll
                for (int m = 0; m < 4; ++m)
#pragma unroll
                    for (int n = 0; n < 2; ++n) acc[a][b][m][n] = (f32x4){0.f, 0.f, 0.f, 0.f};
        cur = nxt; cA = nA; cB = nB; ++ui;
        if constexpr (ALIGN_EPI) { if (wr == 1) PG8_BAR; }
    }
    PG8_WAIT_V(0);
    if constexpr (!ALIGN_EPI) { if (wr == 0) PG8_BAR; }
    PG8_BAR;
#undef base_voffA
#undef base_voffB
#undef PG8_SA
#undef PG8_SB
#undef PG8_STAGE
#undef PG8_STAGE_
#undef PG8_LDA
#undef PG8_LDB
#undef PG8_MMA
#undef PG8_WAIT_V
#undef PG8_WAIT_L
#undef PG8_BAR
#undef PG8_SCHED
}

typedef f32x4 AccT[2][2][4][2];
struct EpiSwiglu {
    static constexpr bool PERM = true;
    bf16_t* G;
    __device__ __forceinline__ void operator()(const AccT& acc, const Unit& u, int wr, int wc, int fr, int fq) const {
        const int r0 = wr * 64 + fr, kt = u.pn * 2 + (wc >> 1), c0 = (wc & 1) * 32 + 8 * fq;
        bf16_t* blk = G + ((size_t)u.pm * (FF / 64) + kt) * (256 * 64) + c0;
#pragma unroll
        for (int ai = 0; ai < 2; ++ai)
#pragma unroll
            for (int m = 0; m < 4; ++m) {
                float v[8];
#pragma unroll
                for (int n = 0; n < 2; ++n)
#pragma unroll
                    for (int k = 0; k < 4; ++k) v[4 * n + k] = siluf_(acc[ai][0][m][n][k]) * acc[ai][1][m][n][k];
                *(u32x4*)(blk + (size_t)(r0 + ai * HALF + m * 16) * 64) = pack8(v);
            }
    }
};
struct EpiRes {
    static constexpr bool PERM = false;
    const float* resP; const float* resS; float* out; float s;
    __device__ __forceinline__ void operator()(const AccT& acc, const Unit& u, int wr, int wc, int fr, int fq) const {
        const int row0 = u.pm * BM + wr * 64 + fr, col0 = u.pn * BM + wc * 32 + 4 * fq;
        const float* res = (u.pm < 64) ? resP : resS;
#pragma unroll
        for (int ai = 0; ai < 2; ++ai) {
            f32x4 x[4][2][2];
#pragma unroll
            for (int m = 0; m < 4; ++m) { const size_t off = (size_t)(row0 + ai * HALF + m * 16) * D + col0;
#pragma unroll
                for (int bj = 0; bj < 2; ++bj)
#pragma unroll
                    for (int n = 0; n < 2; ++n) x[m][bj][n] = *(const f32x4*)(res + off + bj * HALF + n * 16); }
#pragma unroll
            for (int m = 0; m < 4; ++m) { const size_t off = (size_t)(row0 + ai * HALF + m * 16) * D + col0;
#pragma unroll
                for (int bj = 0; bj < 2; ++bj)
#pragma unroll
                    for (int n = 0; n < 2; ++n) *(f32x4*)(out + off + bj * HALF + n * 16) = x[m][bj][n] * ALPHA + acc[ai][bj][m][n] * s; }
            asm volatile("" ::: "memory"); }
    }
};
struct EpiSlab {
    static constexpr bool IDEM = true;
    static constexpr bool PERM = true;
    float* slab;
    __device__ __forceinline__ void operator()(const AccT& acc, const Unit& u, int wr, int wc, int fr, int fq) const {
        const int row0 = wr * 64 + fr, col0 = u.pn * BM + wc * 32 + 8 * fq;
        float* base = slab + (size_t)u.sub * 256 * D;
#pragma unroll
        for (int ai = 0; ai < 2; ++ai)
#pragma unroll
            for (int m = 0; m < 4; ++m) { const size_t off = (size_t)(row0 + ai * HALF + m * 16) * D + col0;
#pragma unroll
                for (int bj = 0; bj < 2; ++bj)
#pragma unroll
                    for (int n = 0; n < 2; ++n) *(f32x4*)(base + off + bj * HALF + n * 4) = acc[ai][bj][m][n]; }
    }
};
struct EpiY {
    static constexpr bool IDEM = true;
    static constexpr bool PERM = true;
    bf16_t* Y;
    __device__ __forceinline__ void operator()(const AccT& acc, const Unit& u, int wr, int wc, int fr, int fq) const {
        const int row0 = u.pm * BM + wr * 64 + fr, col0 = u.pn * BM + wc * 32 + 8 * fq;
#pragma unroll
        for (int ai = 0; ai < 2; ++ai)
#pragma unroll
            for (int m = 0; m < 4; ++m) { const int row = row0 + ai * HALF + m * 16;
#pragma unroll
                for (int bj = 0; bj < 2; ++bj) {
                    u32x4 w; w.x = pk2(acc[ai][bj][m][0][0], acc[ai][bj][m][0][1]); w.y = pk2(acc[ai][bj][m][0][2], acc[ai][bj][m][0][3]);
                    w.z = pk2(acc[ai][bj][m][1][0], acc[ai][bj][m][1][1]); w.w = pk2(acc[ai][bj][m][1][2], acc[ai][bj][m][1][3]);
                    *(u32x4*)(Y + (size_t)row * D + col0 + bj * HALF) = w; } }
    }
};
struct EpiInGate {
    static constexpr bool PERM = true;
    bf16_t* PROJ; bf16_t* GATE; const float* bgate; float* dkP; float* dvP; float* dkS; float* dvS;
    __device__ __forceinline__ void operator()(const AccT& acc, const Unit& u, int wr, int wc, int fr, int fq) const {
        const int row0 = u.pm * BM + wr * 64 + fr;
        if (u.pn < 22) {
            const int col0 = u.pn * BM + wc * 32 + 8 * fq;
            float* f32dst = nullptr; int fcol = 0;
            if (u.pn >= 16 && u.pn < 20) { const bool isk = u.pn < 18; fcol = col0 - (isk ? C_DK : C_DV);
                f32dst = (u.pm < 64) ? (isk ? dkP : dvP) : ((isk ? dkS : dvS) - (size_t)MP * 512); }
#pragma unroll
            for (int ai = 0; ai < 2; ++ai)
#pragma unroll
                for (int m = 0; m < 4; ++m) { const int row = row0 + ai * HALF + m * 16;
#pragma unroll
                    for (int bj = 0; bj < 2; ++bj) {
                        u32x4 w; w.x = pk2(acc[ai][bj][m][0][0], acc[ai][bj][m][0][1]); w.y = pk2(acc[ai][bj][m][0][2], acc[ai][bj][m][0][3]);
                        w.z = pk2(acc[ai][bj][m][1][0], acc[ai][bj][m][1][1]); w.w = pk2(acc[ai][bj][m][1][2], acc[ai][bj][m][1][3]);
                        *(u32x4*)(PROJ + (size_t)row * NIN + col0 + bj * HALF) = w;
                        if (f32dst) { float* p = f32dst + (size_t)row * 512 + fcol + bj * HALF; *(f32x4*)p = acc[ai][bj][m][0]; *(f32x4*)(p + 4) = acc[ai][bj][m][1]; }
                    } }
        } else {
            const int col0 = (u.pn - 22) * BM + wc * 32 + 8 * fq;
            const unsigned lane8 = (unsigned)(((wr * 4 + wc) * 4 + fq) * 16 + fr) * 8u;
            char* gtile = (char*)GATE + ((size_t)u.pm * 32 + (u.pn - 22)) * 65536;
            f32x4 bv[2][2];
#pragma unroll
            for (int bj = 0; bj < 2; ++bj)
#pragma unroll
                for (int n = 0; n < 2; ++n) bv[bj][n] = *(const f32x4*)(bgate + col0 + bj * HALF + 4 * n);
#pragma unroll
            for (int ai = 0; ai < 2; ++ai)
#pragma unroll
                for (int m = 0; m < 4; ++m) { const int row = row0 + ai * HALF + m * 16;
#pragma unroll
                    for (int bj = 0; bj < 2; ++bj) { float v[8];
#pragma unroll
                        for (int n = 0; n < 2; ++n)
#pragma unroll
                            for (int k = 0; k < 4; ++k) v[4 * n + k] = sigmoidf_(acc[ai][bj][m][n][k] + bv[bj][n][k]);
                        *(u32x2*)((gtile + ((ai * 4 + m) * 2 + bj) * 4096) + (size_t)lane8) = pack8_u8(v); } }
        }
    }
};
struct EpiMemKV {
    static constexpr bool PERM = true;
    bf16_t* MKV; float* mk; float* mv;
    __device__ __forceinline__ void operator()(const AccT& acc, const Unit& u, int wr, int wc, int fr, int fq) const {
        const int row0 = u.pm * BM + wr * 64 + fr, col0 = u.pn * BM + wc * 32 + 8 * fq;
        float* dst = (u.pn < 2) ? mk : mv; const int fcol = col0 - (u.pn < 2 ? 0 : 512);
#pragma unroll
        for (int ai = 0; ai < 2; ++ai)
#pragma unroll
            for (int m = 0; m < 4; ++m) { const int row = row0 + ai * HALF + m * 16;
#pragma unroll
                for (int bj = 0; bj < 2; ++bj) {
                    u32x4 w; w.x = pk2(acc[ai][bj][m][0][0], acc[ai][bj][m][0][1]); w.y = pk2(acc[ai][bj][m][0][2], acc[ai][bj][m][0][3]);
                    w.z = pk2(acc[ai][bj][m][1][0], acc[ai][bj][m][1][1]); w.w = pk2(acc[ai][bj][m][1][2], acc[ai][bj][m][1][3]);
                    *(u32x4*)(MKV + (size_t)row * 1024 + col0 + bj * HALF) = w;
                    float* p = dst + (size_t)row * 512 + fcol + bj * HALF; *(f32x4*)p = acc[ai][bj][m][0]; *(f32x4*)(p + 4) = acc[ai][bj][m][1];
                } }
    }
};
struct EpiBranch {
    static constexpr bool IDEM = false;
    static constexpr bool PERM = true;
    bf16_t* GATE; bf16_t* MERGED;
    __device__ __forceinline__ void operator()(const AccT& acc, const Unit& u, int wr, int wc, int fr, int fq) const {
        const int row0 = u.pm * BM + wr * 64 + fr, col0 = u.pn * BM + wc * 32 + 8 * fq;
        const unsigned lane16 = (unsigned)(((wr * 4 + wc) * 4 + fq) * 16 + fr) * 16u;
        const char* gtile = (const char*)GATE + ((size_t)u.pm * 32 + u.sub * 8 + u.pn) * 65536;
        char* otile = (char*)GATE + (size_t)65 * 32 * 65536 + ((size_t)u.pm * 8 + u.pn) * 131072;
        bf16_t* mrow = MERGED + (size_t)row0 * D + col0;
#pragma unroll
        for (int ai = 0; ai < 2; ++ai)
#pragma unroll
          for (int mh = 0; mh < 2; ++mh) {
            u32x2 gw[2][2]; u32x4 ow[2][2];
#pragma unroll
            for (int m2 = 0; m2 < 2; ++m2) { const int m = 2 * mh + m2;
#pragma unroll
                for (int bj = 0; bj < 2; ++bj) { gw[m2][bj] = *(const u32x2*)((gtile + ((ai * 4 + m) * 2 + bj) * 4096) + (size_t)(lane16 >> 1));
                    if (u.sub != 0) ow[m2][bj] = *(const u32x4*)((otile + ((ai * 4 + m) * 2 + bj) * 8192) + (size_t)lane16); } }
#pragma unroll
            for (int m2 = 0; m2 < 2; ++m2) { const int m = 2 * mh + m2;
#pragma unroll
                for (int bj = 0; bj < 2; ++bj) {
                    float gt[8], v[8];
                    unpack8_u8(gw[m2][bj], gt);
#pragma unroll
                    for (int n = 0; n < 2; ++n)
#pragma unroll
                        for (int k = 0; k < 4; ++k) v[4 * n + k] = gt[4 * n + k] * (acc[ai][bj][m][n][k] * (1.0f / 255.0f));
                    if (u.sub != 0) { float old[8]; unpack8(ow[m2][bj], old);
#pragma unroll
                        for (int k = 0; k < 8; ++k) v[k] += old[k]; }
                    if (u.sub == 3) *(u32x4*)(mrow + (size_t)(ai * HALF + m * 16) * D + bj * HALF) = pack8(v);
                    else *(u32x4*)((otile + ((ai * 4 + m) * 2 + bj) * 8192) + (size_t)lane16) = pack8(v);
                } }
            asm volatile("" ::: "memory");
          }
    }
};
struct EpiBranchS {
    static constexpr bool IDEM = true;
    static constexpr bool PERM = true;
    const bf16_t* GATE; bf16_t* P;
    __device__ __forceinline__ void operator()(const AccT& acc, const Unit& u, int wr, int wc, int fr, int fq) const {
        const int r0 = wr * 64 + fr, col0 = u.pn * BM + wc * 32 + 8 * fq;
        const unsigned lane16 = (unsigned)(((wr * 4 + wc) * 4 + fq) * 16 + fr) * 16u;
        const char* gtile = (const char*)GATE + ((size_t)u.pm * 32 + u.sub * 8 + u.pn) * 65536;
#pragma unroll
        for (int ai = 0; ai < 2; ++ai) {
            u32x2 gw[4][2];
#pragma unroll
            for (int m = 0; m < 4; ++m)
#pragma unroll
                for (int bj = 0; bj < 2; ++bj) gw[m][bj] = *(const u32x2*)((gtile + ((ai * 4 + m) * 2 + bj) * 4096) + (size_t)(lane16 >> 1));
#pragma unroll
            for (int m = 0; m < 4; ++m) { const int rp = r0 + ai * HALF + m * 16;
#pragma unroll
                for (int bj = 0; bj < 2; ++bj) {
                    float gt[8], v[8];
                    unpack8_u8(gw[m][bj], gt);
#pragma unroll
                    for (int n = 0; n < 2; ++n)
#pragma unroll
                        for (int k = 0; k < 4; ++k) v[4 * n + k] = gt[4 * n + k] * (acc[ai][bj][m][n][k] * (1.0f / 255.0f));
                    *(u32x4*)(P + ((size_t)u.sub * 256 + rp) * D + col0 + bj * HALF) = pack8(v);
                } }
            asm volatile("" ::: "memory");
        }
    }
};
}

#define XB_TMO      128
#define XB_XCNT(j)  (256  + 64 * (j))
#define XB_XSUB(j)  (1280 + 64 * (j))
#define XB_XGEN(j)  (2304 + 64 * (j))
#define XB_TOP      3328
#define XB_TOPGEN   3392
#define XCD_BAR_WORDS 3456
#define XB_SPIN_CAP (1u << 18)
__device__ __forceinline__ unsigned xb_ld(unsigned* p)              { return __hip_atomic_load(p, __ATOMIC_RELAXED, __HIP_MEMORY_SCOPE_AGENT); }
__device__ __forceinline__ unsigned xb_add(unsigned* p, unsigned v) { return __hip_atomic_fetch_add(p, v, __ATOMIC_RELAXED, __HIP_MEMORY_SCOPE_AGENT); }
__device__ __forceinline__ unsigned xb_xcc_id() { return (unsigned)__builtin_amdgcn_s_getreg((3 << 11) | 20) & 0xFu; }
#define XB_SPIN(cond, bar) do { unsigned _sp = 0; while (cond) { __builtin_amdgcn_s_sleep(1); \
    if ((++_sp & 255u) == 0u) { if (xb_ld(&(bar)[XB_TMO])) break; if (_sp > XB_SPIN_CAP) { atomicAdd(&(bar)[XB_TMO], 1u); break; } } } } while (0)
struct XcdBarrier { unsigned* bar; unsigned x; volatile LAS unsigned* st; };
__device__ __forceinline__ XcdBarrier xcd_barrier_post(unsigned* bar, volatile LAS unsigned* st) {
    XcdBarrier b; b.bar = bar; b.x = xb_xcc_id(); b.st = st;
    if (threadIdx.x == 0) (void)xb_add(&bar[XB_XCNT(b.x)], 1u);
    return b;
}
__device__ __forceinline__ void xcd_barrier_complete(unsigned* bar, unsigned x, unsigned& nloc, unsigned& nx) {
    const unsigned G = gridDim.x * gridDim.y * gridDim.z;
    unsigned sum, cnt, mine, sp = 0u;
    for (;;) {
        sum = 0u; cnt = 0u; mine = 0u;
#pragma unroll
        for (unsigned j = 0; j < 16; ++j) { const unsigned c = xb_ld(&bar[XB_XCNT(j)]); sum += c; cnt += (c > 0u) ? 1u : 0u; mine = (j == x) ? c : mine; }
        if (sum == G) break;
        __builtin_amdgcn_s_sleep(1);
        if ((++sp & 255u) == 0u) { if (xb_ld(&bar[XB_TMO])) break; if (sp > XB_SPIN_CAP) { atomicAdd(&bar[XB_TMO], 1u); break; } }
    }
    nloc = mine > 0u ? mine : 1u; nx = cnt > 0u ? cnt : 1u;
}
__device__ __forceinline__ void xcd_barrier(const XcdBarrier& b) {
    asm volatile("s_waitcnt vmcnt(0)" ::: "memory");
    __syncthreads();
    if (threadIdx.x == 0) {
        unsigned* bar = b.bar;
        __builtin_amdgcn_s_waitcnt(0);
        unsigned nloc = b.st[0], nx = b.st[1];
        if (nloc == 0u) { xcd_barrier_complete(bar, b.x, nloc, nx); b.st[0] = nloc; b.st[1] = nx; }
        const unsigned old = xb_add(&bar[XB_XSUB(b.x)], 1u);
        const unsigned gen = old / nloc;
        if (old + 1u == (gen + 1u) * nloc) {
            __builtin_amdgcn_fence(__ATOMIC_RELEASE, "agent");
            asm volatile("s_waitcnt vmcnt(0)" ::: "memory");
            const unsigned og = xb_add(&bar[XB_TOP], 1u);
            const unsigned tg = og / nx;
            if (og + 1u == (tg + 1u) * nx) xb_add(&bar[XB_TOPGEN], 1u);
            else XB_SPIN(xb_ld(&bar[XB_TOPGEN]) == tg, bar);
            __builtin_amdgcn_fence(__ATOMIC_ACQUIRE, "agent");
            xb_add(&bar[XB_XGEN(b.x)], 1u);
            asm volatile("s_waitcnt vmcnt(0)" ::: "memory");
        } else {
            XB_SPIN(xb_ld(&bar[XB_XGEN(b.x)]) == gen, bar);
            __builtin_amdgcn_fence(__ATOMIC_ACQUIRE, "agent");
            asm volatile("s_waitcnt vmcnt(0)" ::: "memory");
        }
    }
    __syncthreads();
}

struct Args {
    const float* in[30]; float* out; unsigned char* ws; int ph_lo, ph_hi;
};
struct Frame {
    LAS unsigned char* lds; LAS unsigned char* aux; volatile LAS unsigned* MISC;
    gu32* ctl; int tid, lane, wave, G, bid;
    unsigned char* ws; float* out;
    float lam, omi;
};
constexpr int AUX_TBL = 4096;
DI const float* inp(const Frame& F, int k) {
    const LAS unsigned* t = (const LAS unsigned*)(F.aux + AUX_TBL) + 2 * k;
    const unsigned lo = (unsigned)__builtin_amdgcn_readfirstlane((int)t[0]), hi = (unsigned)__builtin_amdgcn_readfirstlane((int)t[1]);
    return (const float*)(const GAS float*)(((unsigned long long)hi << 32) | lo);
}
enum { I_XP = 0, I_XS, I_SCONV, I_SRET, I_CDK, I_CDV, I_CMK, I_CMV, I_MEMP, I_UP1, I_DN1, I_LN1G, I_LN1B, I_WIN, I_CONVW, I_RETG, I_DLAM, I_DSUB, I_WMKV, I_WBR, I_WGATE, I_BGATE, I_WO,
       I_LN2G, I_LN2B, I_UP2, I_DN2, I_LN3G, I_LN3B, I_RELB };

DI int wq_next(Frame& F, int k) {
    __syncthreads();
    if (F.tid == 0) F.MISC[0] = __hip_atomic_fetch_add((unsigned*)(F.ctl + CW_WQ + 64 * k), 1u, RLX_AGENT);
    __syncthreads();
    return __builtin_amdgcn_readfirstlane((int)F.MISC[0]);
}

DI void p0_transpose_item(const float* W, int N, int k0, int n0, bf16* WT, int ldk, int dst_row0, int kofs, LAS float* scr, int lane) {
    const int c4 = lane & 15, rr = lane >> 4;
#pragma unroll 4
    for (int i = 0; i < 16; ++i) { const int kk = 4 * i + rr; const f32x4 v = *(const f32x4*)(W + (size_t)(k0 + kk) * N + n0 + 4 * c4);
        LAS float* d = scr + kk * 65 + 4 * c4; d[0] = v.x; d[1] = v.y; d[2] = v.z; d[3] = v.w; }
    LDS_WAIT(); asm volatile("" ::: "memory");
    const int rs = lane & 15, ch = lane >> 4;
#pragma unroll
    for (int j = 0; j < 8; ++j) { const int sg = j >> 1, kh = j & 1;
        const int rho = 16 * (sg & 1) + rs, q = 32 * (sg >> 1) + pg8::perm32(rho);
        const LAS float* sp = scr + (32 * kh + 8 * ch) * 65 + q;
        u32x4 o; o.x = pk2(sp[0 * 65], sp[1 * 65]); o.y = pk2(sp[2 * 65], sp[3 * 65]); o.z = pk2(sp[4 * 65], sp[5 * 65]); o.w = pk2(sp[6 * 65], sp[7 * 65]);
        const int R0 = dst_row0, k = kofs + k0 + 32 * kh + 8 * ch;
        const int slot = (R0 & 64) + 32 * (sg >> 1) + rho;
        const size_t off = ((size_t)((R0 >> 8) * (ldk >> 6) + (k >> 6)) * 2 + ((R0 >> 7) & 1)) * 16384 + pg8::lds_byte(slot, k & 63);
        *(u32x4*)((char*)WT + off) = o; }
    LDS_WAIT(); asm volatile("" ::: "memory");
}
DI void p0_matrix(const float* W, int K, int N, int r, bf16* WT, int ldk, int mode, int row_base, int kofs, LAS float* scr, int lane) {
    const int nblk = N / 64, kb = r / nblk, nb = r - kb * nblk, n0 = 64 * nb;
    int drow = row_base + n0;
    if (mode == 1) { const int isb = n0 >= FF, nn = n0 - (isb ? FF : 0); drow = 256 * (nn >> 7) + (isb ? 128 : 0) + (nn & 127); }
    p0_transpose_item(W, N, 64 * kb, n0, WT, ldk, drow, kofs, scr, lane);
}
DI void p0_prologue(Frame& F, const Args& a, unsigned char* ws) {
    LAS float* scr = (LAS float*)(F.lds + F.wave * 16640);
    const int gw = F.bid * 8 + F.wave, NGW = F.G * 8;
    constexpr int I_UP = (D / 64) * (NUP / 64), I_DN = (FF / 64) * (D / 64), I_IN = (D / 64) * (NIN / 64), I_GT = 4 * (D / 64) * (D / 64), I_MK = (D / 64) * (1024 / 64),
                  I_BR = 4 * (512 / 64) * (D / 64), I_O = (D / 64) * (D / 64);
    constexpr int PER_LAYER = 2 * I_UP + 2 * I_DN + I_IN + I_GT + I_MK + I_BR + I_O;
    for (int it = gw; it < 2 * PER_LAYER; it += NGW) {
        const int l = it / PER_LAYER; int r = it - l * PER_LAYER;
        unsigned char* wl = ws + WS_W + (size_t)l * LAYER_W;
        if (r < I_UP) { p0_matrix(inp(F, I_UP1) + (size_t)l * D * NUP, D, NUP, r, (bf16*)(wl + W_UP1), D, 1, 0, 0, scr, F.lane); continue; } r -= I_UP;
        if (r < I_DN) { p0_matrix(inp(F, I_DN1) + (size_t)l * FF * D, FF, D, r, (bf16*)(wl + W_DN1), FF, 0, 0, 0, scr, F.lane); continue; } r -= I_DN;
        if (r < I_IN) { p0_matrix(inp(F, I_WIN) + (size_t)l * D * NIN, D, NIN, r, (bf16*)(wl + W_IG), D, 0, 0, 0, scr, F.lane); continue; } r -= I_IN;
        if (r < I_GT) { const int i = r / (I_GT / 4), rr = r - i * (I_GT / 4);
            p0_matrix(inp(F, I_WGATE) + ((size_t)l * 4 + i) * D * D, D, D, rr, (bf16*)(wl + W_IG), D, 0, NIN + i * D, 0, scr, F.lane); continue; } r -= I_GT;
        if (r < I_MK) { p0_matrix(inp(F, I_WMKV) + (size_t)l * D * 1024, D, 1024, r, (bf16*)(wl + W_MKV), D, 0, 0, 0, scr, F.lane); continue; } r -= I_MK;
        if (r < I_BR) { const int i = r / (I_BR / 4), rr = r - i * (I_BR / 4);
            p0_matrix(inp(F, I_WBR) + ((size_t)l * 4 + i) * 512 * D, 512, D, rr, (bf16*)(wl + W_BR), D, 0, 0, i * 512, scr, F.lane); continue; } r -= I_BR;
        if (r < I_O) { p0_matrix(inp(F, I_WO) + (size_t)l * D * D, D, D, r, (bf16*)(wl + W_WO), D, 0, 0, 0, scr, F.lane); continue; } r -= I_O;
        if (r < I_UP) { p0_matrix(inp(F, I_UP2) + (size_t)l * D * NUP, D, NUP, r, (bf16*)(wl + W_UP2), D, 1, 0, 0, scr, F.lane); continue; } r -= I_UP;
        p0_matrix(inp(F, I_DN2) + (size_t)l * FF * D, FF, D, r, (bf16*)(wl + W_DN2), FF, 0, 0, 0, scr, F.lane);
    }
    {
        const size_t gt = (size_t)F.bid * 512 + F.tid, NT = (size_t)F.G * 512;
        bf16* XB = (bf16*)(ws + WS_XB); bf16* MX = (bf16*)(ws + WS_MEMX);
        const size_t nP = (size_t)MP * D / 8, nS = (size_t)MS * D / 8, nM = (size_t)1024 * D / 8;
        for (size_t i = gt; i < nP + nS + nM; i += NT) {
            const float* src; bf16* dst;
            if (i < nP) { src = inp(F, I_XP) + i * 8; dst = XB + i * 8; }
            else if (i < nP + nS) { src = inp(F, I_XS) + (i - nP) * 8; dst = XB + i * 8; }
            else { src = inp(F, I_MEMP) + (i - nP - nS) * 8; dst = MX + (i - nP - nS) * 8; }
            const f32x4 v0 = *(const f32x4*)src, v1 = *(const f32x4*)(src + 4);
            u32x4 w; w.x = pk2(v0.x, v0.y); w.y = pk2(v0.z, v0.w); w.z = pk2(v1.x, v1.y); w.w = pk2(v1.z, v1.w);
            *(u32x4*)dst = w;
        }
        float* rc = (float*)(ws + WS_ROPE); float* rs = rc + 4096 * 64;
        for (size_t i = gt; i < (size_t)4096 * 64; i += NT) {
            const int pos = (int)(i >> 6), j = (int)(i & 63);
            const double invrev = exp2(-(double)j * (13.287712379549449 / 64.0)) * 0.15915494309189535;
            double rev = (double)pos * invrev; rev -= floor(rev);
            const float rf = (float)rev;
            rc[i] = __builtin_amdgcn_cosf(rf); rs[i] = __builtin_amdgcn_sinf(rf);
        }
    }
}

template <bool RESF32>
DI void ln_phase(Frame& F, const void* resP, const void* resS, const bf16* Y, float* outP, float* outS, bf16* XB, const float* g, const float* b, const float* slab, int nslab, float sscale) {
    const int gw = F.bid * 8 + F.wave, NGW = F.G * 8;
    f32x4 gv[8], bv[8];
#pragma unroll
    for (int j = 0; j < 8; ++j) { gv[j] = *(const f32x4*)(g + 4 * F.lane + 256 * j); bv[j] = *(const f32x4*)(b + 4 * F.lane + 256 * j); }
    for (int m = gw; m < M; m += NGW) {
        f32x4 v[8]; float s = 0.f;
        const bool samp = m >= MP;
        if (RESF32) { const f32x4* rr = (const f32x4*)((const float*)(samp ? resS : resP) + (size_t)(samp ? m - MP : m) * D) + F.lane;
#pragma unroll
            for (int j = 0; j < 8; ++j) v[j] = rr[64 * j] * ALPHA;
        } else { const u32x2* rr = (const u32x2*)((const bf16*)(samp ? resS : resP) + (size_t)(samp ? m - MP : m) * D) + F.lane;
#pragma unroll
            for (int j = 0; j < 8; ++j) { const u32x2 x = rr[64 * j]; v[j] = (f32x4){bf_lo(x.x), bf_hi(x.x), bf_lo(x.y), bf_hi(x.y)} * ALPHA; } }
        if (samp) {
            f32x4 acc[8];
#pragma unroll
            for (int j = 0; j < 8; ++j) acc[j] = (f32x4){0.f, 0.f, 0.f, 0.f};
#pragma unroll 4
            for (int k = 0; k < nslab; ++k) { const f32x4* sr = (const f32x4*)(slab + ((size_t)k * 256 + (m - MP)) * D) + F.lane;
#pragma unroll
                for (int j = 0; j < 8; ++j) acc[j] += sr[64 * j]; }
#pragma unroll
            for (int j = 0; j < 8; ++j) v[j] += acc[j] * sscale;
        } else {
            const u32x2* yr = (const u32x2*)(Y + (size_t)m * D) + F.lane;
#pragma unroll
            for (int j = 0; j < 8; ++j) { const u32x2 y = yr[64 * j]; v[j] += (f32x4){bf_lo(y.x), bf_hi(y.x), bf_lo(y.y), bf_hi(y.y)} * sscale; }
        }
#pragma unroll
        for (int j = 0; j < 8; ++j) s += (v[j].x + v[j].y) + (v[j].z + v[j].w);
        const float mean = wave_sum(s) * (1.f / D); float s2 = 0.f;
#pragma unroll
        for (int j = 0; j < 8; ++j) { v[j] = v[j] - mean; s2 += (v[j].x * v[j].x + v[j].y * v[j].y) + (v[j].z * v[j].z + v[j].w * v[j].w); }
        const float rstd = 1.f / sqrtf(wave_sum(s2) * (1.f / D) + LN_EPS);
        float* orow = outP ? (samp ? outS + (size_t)(m - MP) * D : outP + (size_t)m * D) : nullptr;
#pragma unroll
        for (int j = 0; j < 8; ++j) { const f32x4 o = v[j] * rstd * gv[j] + bv[j];
            if (orow) *((f32x4*)orow + F.lane + 64 * j) = o;
            if (XB) { u32x2 w; w.x = pk2(o.x, o.y); w.y = pk2(o.z, o.w); *((u32x2*)(XB + (size_t)m * D) + F.lane + 64 * j) = w; } }
    }
}

DI float gamma_log2(int h) { return h == 0 ? -0.045803689613124746f : h == 1 ? -0.022720076500083512f : h == 2 ? -0.011315313227834106f : -0.005646563141142085f; }
#define MFMA16(a, b, c) __builtin_amdgcn_mfma_f32_16x16x32_bf16((a), (b), (c), 0, 0, 0)
#define MFMA32(a, b, c) __builtin_amdgcn_mfma_f32_32x32x16_bf16((a), (b), (c), 0, 0, 0)

DI void rope8(const bf16* src  , int cp, const float* rc, const float* rs, int pos, float* o1, float* o2) {
    float x1[8], x2[8];
    unpack8(*(const u32x4*)(src + 8 * cp), x1); unpack8(*(const u32x4*)(src + 64 + 8 * cp), x2);
    const f32x4 c0 = *(const f32x4*)(rc + pos * 64 + 8 * cp), c1 = *(const f32x4*)(rc + pos * 64 + 8 * cp + 4);
    const f32x4 s0 = *(const f32x4*)(rs + pos * 64 + 8 * cp), s1 = *(const f32x4*)(rs + pos * 64 + 8 * cp + 4);
    const float cs[8] = {c0.x, c0.y, c0.z, c0.w, c1.x, c1.y, c1.z, c1.w}, sn[8] = {s0.x, s0.y, s0.z, s0.w, s1.x, s1.y, s1.z, s1.w};
#pragma unroll
    for (int j = 0; j < 8; ++j) { o1[j] = x1[j] * cs[j] - x2[j] * sn[j]; o2[j] = x2[j] * cs[j] + x1[j] * sn[j]; }
}
DI void lds_st16(LAS unsigned char* p, float v) { *(LAS unsigned short*)p = (unsigned short)(pk2(v, 0.f) & 0xffffu); }

DI void conv_task(Frame& F, const Args& a, int l, int task) {
    const bf16* PROJ = (const bf16*)(F.ws + WS_G); bf16* Y = (bf16*)(F.ws + WS_Y);
    const float* cw = inp(F, I_CONVW) + (size_t)l * 3 * 512;
    const int c0 = 8 * F.lane, r0 = task * 256 + F.wave * 32;
    float w0[8], w1[8], w2[8];
#pragma unroll
    for (int j = 0; j < 8; ++j) { w0[j] = cw[c0 + j]; w1[j] = cw[512 + c0 + j]; w2[j] = cw[1024 + c0 + j]; }
    float um1[8], um2[8];
#pragma unroll
    for (int j = 0; j < 8; ++j) { um1[j] = 0.f; um2[j] = 0.f; }
    for (int rr = -2; rr < 32; ++rr) {
        const int row = r0 + rr;
        const bool samp = row >= MP;
        const int tl = samp ? ((row - MP) & 15) : (row & 4095);
        if (rr < 0) { if (row < 0 || (r0 >= MP && row < MP)) continue; if ((samp ? ((r0 - MP) & 15) : (r0 & 4095)) + rr < 0) continue; }
        if (rr >= 0 && tl == 0) {
            if (!samp) {
#pragma unroll
                for (int j = 0; j < 8; ++j) { um1[j] = 0.f; um2[j] = 0.f; }
            } else { const float* sc = inp(F, I_SCONV) + (((size_t)l * 16 + ((row - MP) >> 4)) * 2) * 512 + c0;
#pragma unroll
                for (int j = 0; j < 8; ++j) { um2[j] = sc[j]; um1[j] = sc[512 + j]; } }
        }
        float cc[8], ch[8], u[8];
        unpack8(*(const u32x4*)(PROJ + (size_t)row * NIN + C_CC + c0), cc); unpack8(*(const u32x4*)(PROJ + (size_t)row * NIN + C_CH + c0), ch);
#pragma unroll
        for (int j = 0; j < 8; ++j) u[j] = cc[j] * ch[j];
        if (rr >= 0) {
            float cb[8], y[8]; unpack8(*(const u32x4*)(PROJ + (size_t)row * NIN + C_CB + c0), cb);
#pragma unroll
            for (int j = 0; j < 8; ++j) y[j] = cb[j] * (w0[j] * um2[j] + w1[j] * um1[j] + w2[j] * u[j]);
            *(u32x4*)(Y + (size_t)row * D + c0) = pack8(y);
            const int L = samp ? DSEQ : SEQ;
            if (tl >= L - 2) {
                float* dst = samp ? F.out + O_CONVS + (((size_t)l * 16 + ((row - MP) >> 4)) * 2 + (tl - (L - 2))) * 512 + c0
                                  : F.out + O_CONVP + (((size_t)l * 4 + (row >> 12)) * 2 + (tl - (L - 2))) * 512 + c0;
                *(f32x4*)dst = (f32x4){u[0], u[1], u[2], u[3]}; *(f32x4*)(dst + 4) = (f32x4){u[4], u[5], u[6], u[7]};
            }
        }
#pragma unroll
        for (int j = 0; j < 8; ++j) { um2[j] = um1[j]; um1[j] = u[j]; }
    }
}

constexpr int R1_KT = 0, R1_VT = 18432;
DI void ret1_task(Frame& F, const Args& a, int l, int unit) {
    const bf16* PROJ = (const bf16*)(F.ws + WS_G); float* RETKV = (float*)(F.ws + WS_XA);
    const float* rc = (const float*)(F.ws + WS_ROPE); const float* rs = rc + 4096 * 64;
    const int bh = unit >> 6, c = unit & 63, b = bh >> 2, h = bh & 3;
    const int row0 = b * SEQ + c * 64;
    const float lg = gamma_log2(h);
    {
        const int tok = F.tid >> 3, cp = F.tid & 7;
        float o1[8], o2[8];
        rope8(PROJ + (size_t)(row0 + tok) * NIN + C_RK + h * 128, cp, rc, rs, c * 64 + tok, o1, o2);
        const float sc = 0.08838834764831845f * fexp2(lg * (float)(63 - tok));
#pragma unroll
        for (int j = 0; j < 8; ++j) { lds_st16(F.lds + R1_KT + (8 * cp + j) * 144 + tok * 2, o1[j] * sc); lds_st16(F.lds + R1_KT + (64 + 8 * cp + j) * 144 + tok * 2, o2[j] * sc); }
#pragma unroll
        for (int i = 0; i < 2; ++i) { const int id = F.tid + 512 * i, tk = id >> 4, chn = id & 15;
            const u32x4 v = *(const u32x4*)(PROJ + (size_t)(row0 + tk) * NIN + C_RV + h * 128 + 8 * chn);
            const unsigned w[4] = {v.x, v.y, v.z, v.w};
#pragma unroll
            for (int j = 0; j < 4; ++j) { *(LAS unsigned short*)(F.lds + R1_VT + (8 * chn + 2 * j) * 144 + tk * 2) = (unsigned short)(w[j] & 0xffffu);
                                          *(LAS unsigned short*)(F.lds + R1_VT + (8 * chn + 2 * j + 1) * 144 + tk * 2) = (unsigned short)(w[j] >> 16); } }
    }
    __syncthreads();
    const int r16 = F.lane & 15, g = F.lane >> 4, w = F.wave;
    bf16x8 af[2];
#pragma unroll
    for (int ks = 0; ks < 2; ++ks) af[ks] = *(const LAS bf16x8*)(F.lds + R1_VT + (16 * w + r16) * 144 + (32 * ks + 8 * g) * 2);
    float* dst = RETKV + (size_t)unit * 16384;
#pragma unroll
    for (int dt = 0; dt < 8; ++dt) {
        f32x4 acc = {0.f, 0.f, 0.f, 0.f};
#pragma unroll
        for (int ks = 0; ks < 2; ++ks) { const bf16x8 bfr = *(const LAS bf16x8*)(F.lds + R1_KT + (16 * dt + r16) * 144 + (32 * ks + 8 * g) * 2); acc = MFMA16(af[ks], bfr, acc); }
#pragma unroll
        for (int r = 0; r < 4; ++r) dst[(16 * w + 4 * g + r) * 128 + 16 * dt + r16] = acc[r];
    }
}

DI void ret2_task(Frame& F, const Args& a, int l, int task) {
    const float* RETKV = (const float*)(F.ws + WS_XA); bf16* RETS = (bf16*)(F.ws + WS_RETS);
    const int bh = task >> 4, eb = task & 15, h = bh & 3;
    const int e = eb * 8 + (F.tid >> 6), d = 2 * (F.tid & 63);
    const float cdec = fexp2(gamma_log2(h) * 64.f);
    float s0 = 0.f, s1 = 0.f;
    const size_t base = ((size_t)bh * 64) * 16384 + e * 128 + d;
#pragma unroll 8
    for (int c = 0; c < 64; ++c) {
        const f32x2 v = *(const f32x2*)(RETKV + base + (size_t)c * 16384);
        *(unsigned*)(RETS + base + (size_t)c * 16384) = pk2(s0, s1);
        s0 = s0 * cdec + v.x; s1 = s1 * cdec + v.y;
    }
    float* o = F.out + O_RETP + ((size_t)l * 16 + bh) * 16384;
    o[d * 128 + e] = s0; o[(d + 1) * 128 + e] = s1;
}

constexpr int R3_Q = 0, R3_K = 17408, R3_VT = 34816, R3_ST = 53248, R3_ATT = 88064, R3_OF = 97280;
DI void ret_norm_store(Frame& F, const Args& a, int l, int h, int rowbase, int nrows, int of_off) {
    const bf16* PROJ = (const bf16*)(F.ws + WS_G); bf16* Y = (bf16*)(F.ws + WS_Y);
    const int i = F.tid >> 3, part = F.tid & 7;
    if (i < nrows) {
        const LAS float* of = (const LAS float*)(F.lds + of_off) + i * 132 + 16 * part;
        float x[16]; float s = 0.f;
#pragma unroll
        for (int k = 0; k < 16; ++k) { x[k] = of[k]; s += x[k]; }
        s += __shfl_xor(s, 1); s += __shfl_xor(s, 2); s += __shfl_xor(s, 4);
        const float mu = s * (1.f / 128.f); float q = 0.f;
#pragma unroll
        for (int k = 0; k < 16; ++k) { x[k] -= mu; q += x[k] * x[k]; }
        q += __shfl_xor(q, 1); q += __shfl_xor(q, 2); q += __shfl_xor(q, 4);
        const float rstd = 1.f / sqrtf(q * (1.f / 128.f) + LN_EPS);
        const float* gg = inp(F, I_RETG) + (size_t)l * 512 + h * 128 + 16 * part;
        const size_t row = (size_t)rowbase + i;
        float rg[16]; unpack8(*(const u32x4*)(PROJ + row * NIN + C_RG + h * 128 + 16 * part), rg); unpack8(*(const u32x4*)(PROJ + row * NIN + C_RG + h * 128 + 16 * part + 8), rg + 8);
        float y[16];
#pragma unroll
        for (int k = 0; k < 16; ++k) y[k] = siluf_(rg[k]) * (x[k] * rstd * gg[k]);
        *(u32x4*)(Y + row * D + 512 + h * 128 + 16 * part) = pack8(y); *(u32x4*)(Y + row * D + 512 + h * 128 + 16 * part + 8) = pack8(y + 8);
    }
}
DI void ret3_task(Frame& F, const Args& a, int l, int unit) {
    const bf16* PROJ = (const bf16*)(F.ws + WS_G); const bf16* RETS = (const bf16*)(F.ws + WS_RETS);
    const float* rc = (const float*)(F.ws + WS_ROPE); const float* rs = rc + 4096 * 64;
    const int bh = unit >> 6, c = unit & 63, b = bh >> 2, h = bh & 3;
    const int row0 = b * SEQ + c * 64;
    const float lg = gamma_log2(h);
    {
        const int tok = F.tid >> 3, cp = F.tid & 7;
        float o1[8], o2[8];
        rope8(PROJ + (size_t)(row0 + tok) * NIN + C_RQ + h * 128, cp, rc, rs, c * 64 + tok, o1, o2);
        *(LAS u32x4*)(F.lds + R3_Q + tok * 272 + 16 * cp) = pack8(o1); *(LAS u32x4*)(F.lds + R3_Q + tok * 272 + 128 + 16 * cp) = pack8(o2);
        rope8(PROJ + (size_t)(row0 + tok) * NIN + C_RK + h * 128, cp, rc, rs, c * 64 + tok, o1, o2);
#pragma unroll
        for (int j = 0; j < 8; ++j) { o1[j] *= 0.08838834764831845f; o2[j] *= 0.08838834764831845f; }
        *(LAS u32x4*)(F.lds + R3_K + tok * 272 + 16 * cp) = pack8(o1); *(LAS u32x4*)(F.lds + R3_K + tok * 272 + 128 + 16 * cp) = pack8(o2);
#pragma unroll
        for (int i = 0; i < 2; ++i) { const int id = F.tid + 512 * i, tk = id >> 4, chn = id & 15;
            const u32x4 v = *(const u32x4*)(PROJ + (size_t)(row0 + tk) * NIN + C_RV + h * 128 + 8 * chn);
            const unsigned w[4] = {v.x, v.y, v.z, v.w};
#pragma unroll
            for (int j = 0; j < 4; ++j) { *(LAS unsigned short*)(F.lds + R3_VT + (8 * chn + 2 * j) * 144 + tk * 2) = (unsigned short)(w[j] & 0xffffu);
                                          *(LAS unsigned short*)(F.lds + R3_VT + (8 * chn + 2 * j + 1) * 144 + tk * 2) = (unsigned short)(w[j] >> 16); } }
#pragma unroll
        for (int i = 0; i < 4; ++i) { const int id = F.tid + 512 * i, e = id >> 4, chn = id & 15;
            *(LAS u32x4*)(F.lds + R3_ST + e * 272 + 16 * chn) = *(const u32x4*)(RETS + (size_t)unit * 16384 + e * 128 + 8 * chn); }
    }
    __syncthreads();
    const int r16 = F.lane & 15, g = F.lane >> 4, w = F.wave, rb = w & 3, hw = w >> 2;
    bf16x8 qf[4];
#pragma unroll
    for (int ks = 0; ks < 4; ++ks) qf[ks] = *(const LAS bf16x8*)(F.lds + R3_Q + (16 * rb + r16) * 272 + (32 * ks + 8 * g) * 2);
#pragma unroll
    for (int t = 0; t < 2; ++t) { const int cb = 2 * hw + t;
        f32x4 acc = {0.f, 0.f, 0.f, 0.f};
#pragma unroll
        for (int ks = 0; ks < 4; ++ks) { const bf16x8 kf = *(const LAS bf16x8*)(F.lds + R3_K + (16 * cb + r16) * 272 + (32 * ks + 8 * g) * 2); acc = MFMA16(qf[ks], kf, acc); }
        const int j = 16 * cb + r16;
#pragma unroll
        for (int r = 0; r < 4; ++r) { const int i = 16 * rb + 4 * g + r; const float v = (i >= j) ? acc[r] * fexp2(lg * (float)(i - j)) : 0.f;
            lds_st16(F.lds + R3_ATT + i * 144 + j * 2, v); }
    }
    f32x4 oa[4];
#pragma unroll
    for (int t = 0; t < 4; ++t) { const int et = 4 * hw + t; f32x4 acc = {0.f, 0.f, 0.f, 0.f};
#pragma unroll
        for (int ks = 0; ks < 4; ++ks) { const bf16x8 sf = *(const LAS bf16x8*)(F.lds + R3_ST + (16 * et + r16) * 272 + (32 * ks + 8 * g) * 2); acc = MFMA16(qf[ks], sf, acc); }
#pragma unroll
        for (int r = 0; r < 4; ++r) acc[r] *= fexp2(lg * (float)(16 * rb + 4 * g + r + 1));
        oa[t] = acc; }
    __syncthreads();
    bf16x8 af[2];
#pragma unroll
    for (int ks = 0; ks < 2; ++ks) af[ks] = *(const LAS bf16x8*)(F.lds + R3_ATT + (16 * rb + r16) * 144 + (32 * ks + 8 * g) * 2);
#pragma unroll
    for (int t = 0; t < 4; ++t) { const int et = 4 * hw + t;
#pragma unroll
        for (int ks = 0; ks < 2; ++ks) { const bf16x8 vf = *(const LAS bf16x8*)(F.lds + R3_VT + (16 * et + r16) * 144 + (32 * ks + 8 * g) * 2); oa[t] = MFMA16(af[ks], vf, oa[t]); }
#pragma unroll
        for (int r = 0; r < 4; ++r) *((LAS float*)(F.lds + R3_OF) + (16 * rb + 4 * g + r) * 132 + 16 * et + r16) = oa[t][r]; }
    __syncthreads();
    ret_norm_store(F, a, l, h, row0, 64, R3_OF);
}

constexpr int RS_S0 = 0, RS_Q = 65536, RS_K = 73728, RS_V = 81920, RS_ATT = 90112, RS_OF = 91136;
DI void rets_task(Frame& F, const Args& a, int l, int unit) {
    const bf16* PROJ = (const bf16*)(F.ws + WS_G);
    const float* rc = (const float*)(F.ws + WS_ROPE); const float* rs = rc + 4096 * 64;
    const int b = unit >> 2, h = unit & 3, row0 = MP + b * 16;
    const float lg = gamma_log2(h);
    const float* s0g = inp(F, I_SRET) + (((size_t)l * 16 + b) * 4 + h) * 16384;
    LAS float* S0 = (LAS float*)(F.lds + RS_S0); LAS float* Q = (LAS float*)(F.lds + RS_Q); LAS float* K = (LAS float*)(F.lds + RS_K); LAS float* V = (LAS float*)(F.lds + RS_V);
    LAS float* ATT = (LAS float*)(F.lds + RS_ATT); LAS float* OF = (LAS float*)(F.lds + RS_OF);
#pragma unroll
    for (int i = 0; i < 8; ++i) { const int id = F.tid + 512 * i; *(LAS f32x4*)(S0 + 4 * id) = *(const f32x4*)(s0g + 4 * id); }
    if (F.tid < 128) { const int tok = F.tid >> 3, cp = F.tid & 7; float o1[8], o2[8];
        rope8(PROJ + (size_t)(row0 + tok) * NIN + C_RQ + h * 128, cp, rc, rs, PAST + tok, o1, o2);
#pragma unroll
        for (int j = 0; j < 8; ++j) { Q[tok * 128 + 8 * cp + j] = o1[j]; Q[tok * 128 + 64 + 8 * cp + j] = o2[j]; }
        rope8(PROJ + (size_t)(row0 + tok) * NIN + C_RK + h * 128, cp, rc, rs, PAST + tok, o1, o2);
#pragma unroll
        for (int j = 0; j < 8; ++j) { K[tok * 128 + 8 * cp + j] = o1[j] * 0.08838834764831845f; K[tok * 128 + 64 + 8 * cp + j] = o2[j] * 0.08838834764831845f; } }
    { const int tok = F.tid >> 5, c4 = F.tid & 31; const u32x2 v = *(const u32x2*)(PROJ + (size_t)(row0 + tok) * NIN + C_RV + h * 128 + 4 * c4);
      V[tok * 128 + 4 * c4] = bf_lo(v.x); V[tok * 128 + 4 * c4 + 1] = bf_hi(v.x); V[tok * 128 + 4 * c4 + 2] = bf_lo(v.y); V[tok * 128 + 4 * c4 + 3] = bf_hi(v.y); }
    __syncthreads();
    if (F.tid < 256) { const int i = F.tid >> 4, j = F.tid & 15; float s = 0.f;
        for (int d = 0; d < 128; ++d) s += Q[i * 128 + d] * K[j * 128 + d];
        ATT[i * 16 + j] = (i >= j) ? s * fexp2(lg * (float)(i - j)) : 0.f; }
    __syncthreads();
    {
        const int e = F.tid & 127, i0 = 4 * (F.tid >> 7);
        float o[4] = {0.f, 0.f, 0.f, 0.f};
        for (int d = 0; d < 128; ++d) { const float s = S0[d * 128 + e];
#pragma unroll
            for (int k = 0; k < 4; ++k) o[k] += Q[(i0 + k) * 128 + d] * s; }
#pragma unroll
        for (int k = 0; k < 4; ++k) { o[k] *= fexp2(lg * (float)(i0 + k + 1));
            for (int j = 0; j <= i0 + k; ++j) o[k] += ATT[(i0 + k) * 16 + j] * V[j * 128 + e];
            OF[(i0 + k) * 132 + e] = o[k]; }
        float* so = F.out + O_RETS + (((size_t)l * 16 + b) * 4 + h) * 16384;
        const float g16 = fexp2(lg * 16.f);
        float vv[16];
#pragma unroll
        for (int j = 0; j < 16; ++j) vv[j] = V[j * 128 + e] * fexp2(lg * (float)(15 - j));
        for (int dd = 0; dd < 32; ++dd) { const int d = 32 * (F.tid >> 7) + dd; float s = S0[d * 128 + e] * g16;
#pragma unroll
            for (int j = 0; j < 16; ++j) s += K[j * 128 + d] * vv[j];
            so[d * 128 + e] = s; }
    }
    __syncthreads();
    ret_norm_store(F, a, l, h, row0, 16, RS_OF);
}

constexpr int AT_KT = 0, AT_VT = 34816, AT_OXW = 16896;
struct AttnCfg {
    int nqt, nmap, nsplit;
    int nq;
    const bf16* qbase; int ldq;
    int qcol0, qcol1;
    int kcol0, kcol1;
    float qscale;
    int nkeys;
    const float* kf; const float* vf; int ldf; int nf32;
    const bf16* kb; const bf16* vb; int ldb;
    const bf16* vt; int ldvt;
    int qpos0;
    int bias;
    int chunkmask;
};
DI void attn_stage(Frame& F, const AttnCfg& C, int st) {
#pragma unroll
    for (int i = 0; i < 4; ++i) {
        const int id = F.tid + 512 * i, row = id >> 4, ch = id & 15, key = st * 128 + row;
        u32x4 kw = {0u, 0u, 0u, 0u}, vw = {0u, 0u, 0u, 0u};
        if (key < C.nf32) {
            const float* kp = C.kf + (size_t)key * C.ldf + 8 * ch; const float* vp = C.vf + (size_t)key * C.ldf + 8 * ch;
            const f32x4 k0 = *(const f32x4*)kp, k1 = *(const f32x4*)(kp + 4), v0 = *(const f32x4*)vp, v1 = *(const f32x4*)(vp + 4);
            kw.x = pk2(k0.x, k0.y); kw.y = pk2(k0.z, k0.w); kw.z = pk2(k1.x, k1.y); kw.w = pk2(k1.z, k1.w);
            vw.x = pk2(v0.x, v0.y); vw.y = pk2(v0.z, v0.w); vw.z = pk2(v1.x, v1.y); vw.w = pk2(v1.z, v1.w);
        } else if (key < C.nkeys) {
            kw = *(const u32x4*)(C.kb + (size_t)(key - C.nf32) * C.ldb + 8 * ch); vw = *(const u32x4*)(C.vb + (size_t)(key - C.nf32) * C.ldb + 8 * ch);
        }
        *(LAS u32x4*)(F.lds + AT_KT + row * 272 + 16 * ch) = kw;
        const unsigned w[4] = {vw.x, vw.y, vw.z, vw.w};
#pragma unroll
        for (int j = 0; j < 4; ++j) { *(LAS unsigned short*)(F.lds + AT_VT + (8 * ch + 2 * j) * 264 + row * 2) = (unsigned short)(w[j] & 0xffffu);
                                      *(LAS unsigned short*)(F.lds + AT_VT + (8 * ch + 2 * j + 1) * 264 + row * 2) = (unsigned short)(w[j] >> 16); }
    }
}

constexpr int AT_BUF = 69632;
template <int KS, bool PF>
DI void attn_run(Frame& F, const AttnCfg& C) {
    const int w = F.wave, r = F.lane & 31, hh = F.lane >> 5;
    const int per_qt = C.nmap * C.nsplit, qt = w / per_qt, rem = w - qt * per_qt, split = rem / C.nmap, map = rem - split * C.nmap;
    const bool active = qt < C.nqt;
    const int kcolm = map ? C.kcol1 : C.kcol0;
    bf16x8 qf[KS];
    {
        const int qr = qt * 32 + (r < C.nq ? r : C.nq - 1);
        const bf16* qp = C.qbase + (size_t)(active ? qr : 0) * C.ldq + (map ? C.qcol1 : C.qcol0) + 8 * hh;
#pragma unroll
        for (int ks = 0; ks < KS; ++ks) { float v[8]; unpack8(*(const u32x4*)(qp + 16 * ks), v);
#pragma unroll
            for (int j = 0; j < 8; ++j) v[j] *= C.qscale;
            qf[ks] = __builtin_bit_cast(bf16x8, pack8(v)); }
    }
    f32x16 o[4];
#pragma unroll
    for (int et = 0; et < 4; ++et)
#pragma unroll
        for (int i = 0; i < 16; ++i) o[et][i] = 0.f;
    float m = 0.f, lsum = 0.f; bool first = true;
    const int qpos_t = C.qpos0 + 32 * qt;
    const int klim = C.chunkmask ? 64 * ((qpos_t >> 6) + 1) : C.nkeys;
    const int nst = (C.nkeys + 127) >> 7;
    const LAS float* TB = (const LAS float*)(F.aux + AUX_BIAS);
#define AT_DMA(st_, bo_) do { _Pragma("unroll") for (int j = 0; j < 5; ++j) { const int blk = w + 8 * j; if (blk < 34) { const int c = blk * 64 + F.lane, row = c / 17, cc = c - row * 17, cq = cc < 16 ? cc : 15; \
        __builtin_amdgcn_global_load_lds((const unsigned*)(C.kb + (size_t)((st_) * 128 + row) * C.ldb + 8 * cq), (LAS unsigned*)(F.lds + (bo_) + AT_KT + blk * 1024), 16, 0, 0); \
        __builtin_amdgcn_global_load_lds((const unsigned*)(C.vt + (size_t)row * C.ldvt + (st_) * 128 + 8 * cq), (LAS unsigned*)(F.lds + (bo_) + AT_KT + 34816 + blk * 1024), 16, 0, 0); } } } while (0)
    if (PF) { __syncthreads(); AT_DMA(0, 0); VM_WAIT(); __syncthreads(); }
    for (int st = 0; st < nst; ++st) {
        const int bo = PF ? (st & 1) * AT_BUF : 0;
        if (!PF) { __syncthreads(); attn_stage(F, C, st); __syncthreads(); }
        else if (st + 1 < nst) AT_DMA(st + 1, ((st + 1) & 1) * AT_BUF);
        if (active) {
#pragma unroll 1
        for (int sb = 0; sb < 4; ++sb) {
            if (C.nsplit > 1 && sb != split) continue;
            const int kg = st * 128 + sb * 32;
            if (kg >= klim) continue;
            const bool fastb = C.bias && (kg + 31 - qpos_t <= -128);
            const float s0 = (fastb ? TB[0] : 0.f) - m;
            bf16x8 kfr[KS];
#pragma unroll
            for (int ks = 0; ks < KS; ++ks) kfr[ks] = *(const LAS bf16x8*)(F.lds + bo + AT_KT + (sb * 32 + r) * 272 + (kcolm + 16 * ks + 8 * hh) * 2);
            f32x16 s;
#pragma unroll
            for (int i = 0; i < 16; ++i) s[i] = s0;
#pragma unroll
            for (int ks = 0; ks < KS; ++ks) s = MFMA32(kfr[ks], qf[ks], s);
            u32x2 vlo[2][2], vhi[2][2];
#pragma unroll
            for (int et = 0; et < 2; ++et)
#pragma unroll
                for (int s2 = 0; s2 < 2; ++s2) { const LAS unsigned char* vp = F.lds + bo + AT_VT + (32 * et + r) * (PF ? 272 : 264) + (sb * 32 + 16 * s2 + 4 * hh) * 2;
                    vlo[et][s2] = *(const LAS u32x2*)vp; vhi[et][s2] = *(const LAS u32x2*)(vp + 16); }
            if (C.bias && !fastb) {
#pragma unroll
                for (int i = 0; i < 16; ++i) { const int key = kg + (i & 3) + 8 * (i >> 2) + 4 * hh; int idx = key - (qpos_t + r) + 128; idx = idx < 0 ? 0 : (idx > 191 ? 191 : idx); s[i] += TB[idx]; }
            }
            if (kg + 32 > C.nkeys) {
#pragma unroll
                for (int i = 0; i < 16; ++i) { const int key = kg + (i & 3) + 8 * (i >> 2) + 4 * hh; if (key >= C.nkeys) s[i] = -1e30f; }
            }
            float mx = s[0];
#pragma unroll
            for (int i = 1; i < 16; ++i) mx = fmaxf(mx, s[i]);
            { auto rr = __builtin_amdgcn_permlane32_swap(__float_as_uint(mx), __float_as_uint(mx), false, false); mx = fmaxf(__uint_as_float(rr[0]), __uint_as_float(rr[1])); }
            if (first || __any(mx > 8.0f)) {
                const float dl = first ? mx : fmaxf(mx, 0.f), al = fexp2(-dl); m += dl; lsum *= al;
#pragma unroll
                for (int i = 0; i < 16; ++i) s[i] -= dl;
#pragma unroll
                for (int et = 0; et < 4; ++et)
#pragma unroll
                    for (int i = 0; i < 16; ++i) o[et][i] *= al;
                first = false; }
            float p[16]; float ps = 0.f;
#pragma unroll
            for (int i = 0; i < 16; ++i) { p[i] = fexp2(s[i]); ps += p[i]; }
            lsum += ps;
            bf16x8 pf[2];
            pf[0] = __builtin_bit_cast(bf16x8, pack8(p)); pf[1] = __builtin_bit_cast(bf16x8, pack8(p + 8));
            u32x2 wlo[2][2], whi[2][2];
#pragma unroll
            for (int et = 0; et < 2; ++et)
#pragma unroll
                for (int s2 = 0; s2 < 2; ++s2) { const LAS unsigned char* vp = F.lds + bo + AT_VT + (32 * (et + 2) + r) * (PF ? 272 : 264) + (sb * 32 + 16 * s2 + 4 * hh) * 2;
                    wlo[et][s2] = *(const LAS u32x2*)vp; whi[et][s2] = *(const LAS u32x2*)(vp + 16); }
#pragma unroll
            for (int et = 0; et < 2; ++et)
#pragma unroll
                for (int s2 = 0; s2 < 2; ++s2) {
                    const u32x4 vv = {vlo[et][s2].x, vlo[et][s2].y, vhi[et][s2].x, vhi[et][s2].y};
                    o[et] = MFMA32(__builtin_bit_cast(bf16x8, vv), pf[s2], o[et]);
                }
#pragma unroll
            for (int et = 0; et < 2; ++et)
#pragma unroll
                for (int s2 = 0; s2 < 2; ++s2) {
                    const u32x4 vv = {wlo[et][s2].x, wlo[et][s2].y, whi[et][s2].x, whi[et][s2].y};
                    o[et + 2] = MFMA32(__builtin_bit_cast(bf16x8, vv), pf[s2], o[et + 2]);
                }
        }
        }
        if (PF) { VM_WAIT(); __syncthreads(); }
    }
#undef AT_DMA
    if (!PF) __syncthreads();
    { auto rr = __builtin_amdgcn_permlane32_swap(__float_as_uint(lsum), __float_as_uint(lsum), false, false); lsum = __uint_as_float(rr[0]) + __uint_as_float(rr[1]); }
    LAS float* OX = (LAS float*)(F.lds + w * AT_OXW);
#pragma unroll
    for (int et = 0; et < 4; ++et)
#pragma unroll
        for (int i = 0; i < 16; ++i) OX[(32 * et + (i & 3) + 8 * (i >> 2) + 4 * hh) * 33 + r] = o[et][i];
    if (hh == 0) { LAS float* ML = (LAS float*)(F.aux + AUX_ML) + (w * 32 + r) * 2; ML[0] = m; ML[1] = lsum; }
    __syncthreads();
}
DI void attn_combine(Frame& F, const AttnCfg& C, int qt, int rq, int map, float& v0, float& v1) {
    const LAS float* MLb = (const LAS float*)(F.aux + AUX_ML);
    const int per_qt = C.nmap * C.nsplit;
    float mstar = -1e30f;
    for (int sp = 0; sp < C.nsplit; ++sp) { const int ww = qt * per_qt + sp * C.nmap + map; mstar = fmaxf(mstar, MLb[(ww * 32 + rq) * 2]); }
    float L = 0.f, a0 = 0.f, a1 = 0.f;
    for (int sp = 0; sp < C.nsplit; ++sp) { const int ww = qt * per_qt + sp * C.nmap + map; const float wgt = fexp2(MLb[(ww * 32 + rq) * 2] - mstar);
        L += wgt * MLb[(ww * 32 + rq) * 2 + 1];
        const LAS float* OX = (const LAS float*)(F.lds + ww * AT_OXW);
        a0 += wgt * OX[(2 * F.lane) * 33 + rq]; a1 += wgt * OX[(2 * F.lane + 1) * 33 + rq]; }
    const float inv = 1.f / L; v0 = a0 * inv; v1 = a1 * inv;
}

DI void fill_bias_table(Frame& F, const Args& a, int h) {
    if (F.tid < 192) { const int rel = F.tid - 128, n = rel < 0 ? -rel : rel;
        int bk = n < 8 ? n : (n < 12 ? 8 : n < 16 ? 9 : n < 23 ? 10 : n < 32 ? 11 : n < 46 ? 12 : n < 64 ? 13 : n < 91 ? 14 : 15);
        if (rel > 0) bk += 16;
        ((LAS float*)(F.aux + AUX_BIAS))[F.tid] = inp(F, I_RELB)[bk * 4 + h] * LOG2E; }
}
DI void diff_lambda(const Frame& F, int l, float& lam, float& one_minus_init) {
    const float* lp = inp(F, I_DLAM) + (size_t)l * 256; float s1 = 0.f, s2 = 0.f;
    for (int i = 0; i < 64; ++i) { s1 += lp[i] * lp[64 + i]; s2 += lp[128 + i] * lp[192 + i]; }
    const float li = (l == 0) ? 0.2f : 0.35550906758730926f;
    lam = expf(s1) - expf(s2) + li; one_minus_init = 1.f - li;
}
DI void diff_finish(Frame& F, const Args& a, const AttnCfg& C, int l, int h, size_t yrow0, int nq_total) {
    const float lam = F.lam, omi = F.omi;
    bf16* Y = (bf16*)(F.ws + WS_Y);
    const float g0 = inp(F, I_DSUB)[(size_t)l * 128 + 2 * F.lane], g1 = inp(F, I_DSUB)[(size_t)l * 128 + 2 * F.lane + 1];
    for (int q = F.wave; q < nq_total; q += 8) {
        const int qt = q >> 5, rq = q & 31;
        float a0, a1, b0, b1; attn_combine(F, C, qt, rq, 0, a0, a1); attn_combine(F, C, qt, rq, 1, b0, b1);
        const float x0 = a0 - lam * b0, x1 = a1 - lam * b1;
        const float ss = wave_sum(x0 * x0 + x1 * x1);
        const float rn = 1.f / sqrtf(ss * (1.f / 128.f) + LN_EPS) * omi;
        *(unsigned*)(Y + (yrow0 + q) * D + 1024 + h * 128 + 2 * F.lane) = pk2(x0 * rn * g0, x1 * rn * g1);
    }
}
DI void mem_finish(Frame& F, const Args& a, const AttnCfg& C, int h, size_t yrow0, int nq_total) {
    bf16* Y = (bf16*)(F.ws + WS_Y);
    for (int q = F.wave; q < nq_total; q += 8) {
        const int qt = q >> 5, rq = q & 31; float a0, a1; attn_combine(F, C, qt, rq, 0, a0, a1);
        *(unsigned*)(Y + (yrow0 + q) * D + 1536 + h * 128 + 2 * F.lane) = pk2(a0, a1);
    }
}


DI void vtrans_task(Frame& F, int task) {
    const bf16* PROJ = (const bf16*)(F.ws + WS_G); bf16* VT = (bf16*)(F.ws + WS_VT);
    const int bh = task >> 4, kb = task & 15, b = bh >> 2, h = bh & 3;
#pragma unroll
    for (int i = 0; i < 8; ++i) { const int id = F.tid + 512 * i, key = id >> 4, ch = id & 15;
        const u32x4 v = *(const u32x4*)(PROJ + (size_t)(b * SEQ + kb * 256 + key) * NIN + C_DV + h * 128 + 8 * ch);
        const unsigned w[4] = {v.x, v.y, v.z, v.w};
#pragma unroll
        for (int j = 0; j < 4; ++j) { *(LAS unsigned short*)(F.lds + (8 * ch + 2 * j) * 528 + key * 2) = (unsigned short)(w[j] & 0xffffu);
                                      *(LAS unsigned short*)(F.lds + (8 * ch + 2 * j + 1) * 528 + key * 2) = (unsigned short)(w[j] >> 16); } }
    __syncthreads();
#pragma unroll
    for (int i = 0; i < 8; ++i) { const int id = F.tid + 512 * i, e = id >> 5, c32 = id & 31;
        *(u32x4*)(VT + ((size_t)(bh * 128 + e)) * 4096 + kb * 256 + 8 * c32) = *(const LAS u32x4*)(F.lds + e * 528 + 16 * c32); }
}

DI void diffp_task(Frame& F, const Args& a, int l, int task) {
    const bf16* PROJ = (const bf16*)(F.ws + WS_G);
    const int qb = 31 - (task >> 4), bh = task & 15, b = bh >> 2, h = bh & 3;
    __syncthreads(); fill_bias_table(F, a, h);
    AttnCfg C; C.nqt = 4; C.nmap = 2; C.nsplit = 1; C.nq = 32;
    C.qbase = PROJ + (size_t)(b * SEQ + qb * 128) * NIN; C.ldq = NIN; C.qcol0 = C_DQ + h * 128; C.qcol1 = C_DQ + h * 128 + 64; C.kcol0 = 0; C.kcol1 = 64;
    C.qscale = 0.125f * LOG2E; C.nkeys = 128 * (qb + 1); C.kf = nullptr; C.vf = nullptr; C.ldf = 0; C.nf32 = 0;
    C.kb = PROJ + (size_t)(b * SEQ) * NIN + C_DK + h * 128; C.vb = PROJ + (size_t)(b * SEQ) * NIN + C_DV + h * 128; C.ldb = NIN;
    C.qpos0 = qb * 128; C.bias = 1; C.chunkmask = 1;
    C.vt = (const bf16*)(F.ws + WS_VT) + (size_t)(bh * 128) * 4096; C.ldvt = 4096;
    attn_run<4, true>(F, C);
    diff_finish(F, a, C, l, h, (size_t)b * SEQ + qb * 128, 128);
}
DI void diffs_task(Frame& F, const Args& a, int l, int task) {
    const bf16* PROJ = (const bf16*)(F.ws + WS_G);
    const int b = task >> 2, h = task & 3;
    __syncthreads(); fill_bias_table(F, a, h);
    AttnCfg C; C.nqt = 1; C.nmap = 2; C.nsplit = 4; C.nq = 16;
    C.qbase = PROJ + (size_t)(MP + b * 16) * NIN; C.ldq = NIN; C.qcol0 = C_DQ + h * 128; C.qcol1 = C_DQ + h * 128 + 64; C.kcol0 = 0; C.kcol1 = 64;
    C.qscale = 0.125f * LOG2E; C.nkeys = PAST + DSEQ;
    C.kf = inp(F, I_CDK) + (((size_t)l * 16 + b) * PAST * 4 + h) * 128; C.vf = inp(F, I_CDV) + (((size_t)l * 16 + b) * PAST * 4 + h) * 128; C.ldf = 512; C.nf32 = PAST;
    C.kb = PROJ + (size_t)(MP + b * 16) * NIN + C_DK + h * 128; C.vb = PROJ + (size_t)(MP + b * 16) * NIN + C_DV + h * 128; C.ldb = NIN;
    C.qpos0 = PAST; C.bias = 1; C.chunkmask = 0;
    C.vt = nullptr; C.ldvt = 0;
    attn_run<4, false>(F, C);
    diff_finish(F, a, C, l, h, (size_t)MP + b * 16, 16);
}
DI void memp_task(Frame& F, const Args& a, int l, int task) {
    const bf16* PROJ = (const bf16*)(F.ws + WS_G); const bf16* MKV = (const bf16*)(F.ws + WS_MEMKV);
    const int qb = task >> 4, bh = task & 15, b = bh >> 2, h = bh & 3;
    AttnCfg C; C.nqt = 8; C.nmap = 1; C.nsplit = 1; C.nq = 32;
    C.qbase = PROJ + (size_t)(b * SEQ + qb * 256) * NIN; C.ldq = NIN; C.qcol0 = C_MQ + h * 128; C.qcol1 = 0; C.kcol0 = 0; C.kcol1 = 0;
    C.qscale = 0.08838834764831845f * LOG2E; C.nkeys = 256; C.kf = nullptr; C.vf = nullptr; C.ldf = 0; C.nf32 = 0;
    C.kb = MKV + (size_t)(b * 256) * 1024 + h * 128; C.vb = MKV + (size_t)(b * 256) * 1024 + 512 + h * 128; C.ldb = 1024;
    C.qpos0 = 0; C.bias = 0; C.chunkmask = 0;
    C.vt = nullptr; C.ldvt = 0;
    attn_run<8, false>(F, C);
    mem_finish(F, a, C, h, (size_t)b * SEQ + qb * 256, 256);
}
DI void mems_task(Frame& F, const Args& a, int l, int task) {
    const bf16* PROJ = (const bf16*)(F.ws + WS_G);
    const int b = task >> 2, h = task & 3;
    AttnCfg C; C.nqt = 1; C.nmap = 1; C.nsplit = 4; C.nq = 16;
    C.qbase = PROJ + (size_t)(MP + b * 16) * NIN; C.ldq = NIN; C.qcol0 = C_MQ + h * 128; C.qcol1 = 0; C.kcol0 = 0; C.kcol1 = 0;
    C.qscale = 0.08838834764831845f * LOG2E; C.nkeys = 256;
    C.kf = inp(F, I_CMK) + (((size_t)l * 16 + b) * 256 * 4 + h) * 128; C.vf = inp(F, I_CMV) + (((size_t)l * 16 + b) * 256 * 4 + h) * 128; C.ldf = 512; C.nf32 = 256;
    C.kb = nullptr; C.vb = nullptr; C.ldb = 0; C.qpos0 = 0; C.bias = 0; C.chunkmask = 0;
    C.vt = nullptr; C.ldvt = 0;
    attn_run<8, false>(F, C);
    mem_finish(F, a, C, h, (size_t)MP + b * 16, 16);
}

#ifndef PROBE_REPS
#define PROBE_REPS {1,1,1,1,1,1,1,1,1,1,1,1,1,1}
#endif
constexpr int REPS[14] = PROBE_REPS;
#ifndef PROBE_SUBREP
#define PROBE_SUBREP {1,1,1}
#endif
constexpr int SUBREP[3] = PROBE_SUBREP;
#define FRESH() do { int t_ = threadIdx.x; asm volatile("" : "+v"(t_)); F.tid = t_; F.lane = t_ & 63; F.wave = __builtin_amdgcn_readfirstlane(t_ >> 6); { unsigned long long wsi_ = (unsigned long long)args.ws; asm volatile("" : "+s"(wsi_)); ws = (unsigned char*)(GAS unsigned char*)wsi_; } F.ws = ws; F.out = (float*)inp(F, 30); \
    XB = (bf16*)(ws + WS_XB); Gb = (bf16*)(ws + WS_G); GATE = (bf16*)(ws + WS_GATE); Yb = (bf16*)(ws + WS_Y); wl = ws + WS_W + (size_t)l * LAYER_W; } while (0)
#define SEAM() do { XcdBarrier b_ = bar; unsigned long long bi_ = (unsigned long long)b_.bar; asm volatile("" : "+s"(bi_)); b_.bar = (unsigned*)(GAS unsigned*)bi_; xcd_barrier(b_); } while (0)
#define PHASE_LOCALS unsigned char* ws; bf16* XB; bf16* Gb; bf16* GATE; bf16* Yb; unsigned char* wl; const int nMall = M / 256; (void)Yb; (void)nMall; (void)XB; (void)Gb; (void)GATE; (void)wl

DI void ffn_half(Frame& F, const Args& args, const XcdBarrier& bar, const int l, const int half) {
    PHASE_LOCALS;
    for (int rep = 0; rep < REPS[1]; ++rep) { if (rep) SEAM(); FRESH();
        { pg8::Gemm g{XB, (const bf16*)(wl + (half ? W_UP2 : W_UP1)), D, D, D / 64, 128, 256 * D * 2}; pg8::StaticOrder S; S.init(MP / 256, NUP / 256, F.G, F.bid);
          pg8::EpiSwiglu E{Gb}; pg8::gemm_phase<pg8::EpiSwiglu, pg8::StaticOrder, true>(F.lds, F.tid, g, S, E); }
        { pg8::Gemm g{XB, (const bf16*)(wl + (half ? W_UP2 : W_UP1)), D, D, D / 64, 128, 256 * D * 2}; pg8::StaticOrder S; S.init_splitk(1, NUP / 256, F.G, F.G - 1 - F.bid, 0, MP / 256);
          pg8::EpiSwiglu E{Gb}; pg8::gemm_phase<pg8::EpiSwiglu, pg8::StaticOrder, true>(F.lds, F.tid, g, S, E); } }
    SEAM();
    { FRESH();
        { pg8::Gemm g{Gb, (const bf16*)(wl + (half ? W_DN2 : W_DN1)), 64, FF, FF / 64, 32768, (FF / 64) * 32768}; pg8::StaticOrder S; S.init(MP / 256, D / 256, F.G, F.bid, 1, 0, 4);
          pg8::EpiY E{GATE}; pg8::gemm_phase<pg8::EpiY, pg8::StaticOrder, true>(F.lds, F.tid, g, S, E); }
        { pg8::Gemm g{Gb, (const bf16*)(wl + (half ? W_DN2 : W_DN1)), 64, FF, 8, 32768, (FF / 64) * 32768}; pg8::StaticOrder S; S.init_splitk(11, D / 256, F.G, F.G - 1 - F.bid, 512, MP / 256);
          pg8::EpiSlab E{(float*)(ws + WS_SLAB)}; pg8::gemm_phase<pg8::EpiSlab, pg8::StaticOrder, true>(F.lds, F.tid, g, S, E); } }
    SEAM();
    { FRESH();
        const float* lg = inp(F, half ? I_LN3G : I_LN1G) + (size_t)l * D; const float* lb = inp(F, half ? I_LN3B : I_LN1B) + (size_t)l * D;
        const bool fin = (l == 1 && half == 1);
        if (l == 0 && half == 0) ln_phase<true>(F, inp(F, I_XP), inp(F, I_XS), GATE, nullptr, nullptr, XB, lg, lb, (const float*)(ws + WS_SLAB), 11, 0.5f);
        else ln_phase<false>(F, XB, XB + (size_t)MP * D, GATE, fin ? F.out + O_YP : nullptr, fin ? F.out + O_YS : nullptr, fin ? nullptr : XB, lg, lb, (const float*)(ws + WS_SLAB), 11, 0.5f); }
}
DI void mixer_block(Frame& F, const Args& args, const XcdBarrier& bar, const int l) {
    PHASE_LOCALS;
    for (int rep = 0; rep < REPS[4]; ++rep) { if (rep) SEAM(); FRESH();
        { pg8::Gemm g{XB, (const bf16*)(wl + W_IG), D, D, D / 64, 128, 256 * D * 2}; pg8::StaticOrder S; S.init(MP / 256, NIG / 256, F.G, F.bid);
          pg8::EpiInGate E{Gb, GATE, inp(F, I_BGATE) + (size_t)l * NGATE, F.out + O_DKP + (size_t)l * MP * 512, F.out + O_DVP + (size_t)l * MP * 512,
                           F.out + O_DKS + (size_t)l * MS * 512, F.out + O_DVS + (size_t)l * MS * 512};
          pg8::gemm_phase<pg8::EpiInGate, pg8::StaticOrder, true>(F.lds, F.tid, g, S, E); }
        { pg8::Gemm g{XB, (const bf16*)(wl + W_IG), D, D, D / 64, 128, 256 * D * 2}; pg8::StaticOrder S; S.init_splitk(1, NIG / 256, F.G, F.G - 1 - F.bid, 0, MP / 256);
          pg8::EpiInGate E{Gb, GATE, inp(F, I_BGATE) + (size_t)l * NGATE, F.out + O_DKP + (size_t)l * MP * 512, F.out + O_DVP + (size_t)l * MP * 512,
                           F.out + O_DKS + (size_t)l * MS * 512, F.out + O_DVS + (size_t)l * MS * 512};
          pg8::gemm_phase<pg8::EpiInGate, pg8::StaticOrder, true>(F.lds, F.tid, g, S, E); }
        { pg8::Gemm g{(const bf16*)(ws + WS_MEMX), (const bf16*)(wl + W_MKV), D, D, D / 64, 128, 256 * D * 2}; pg8::StaticOrder S; S.init(4, 4, F.G, F.G - 1 - 54 - F.bid < 0 ? F.G : F.G - 1 - 54 - F.bid);
          pg8::EpiMemKV E{(bf16*)(ws + WS_MEMKV), F.out + O_MKP + (size_t)l * 1024 * 512, F.out + O_MVP + (size_t)l * 1024 * 512};
          pg8::gemm_phase<pg8::EpiMemKV, pg8::StaticOrder, true>(F.lds, F.tid, g, S, E); }
    }
    SEAM();
    for (int rep = 0; rep < REPS[5]; ++rep) { if (rep) SEAM(); FRESH();
        { const int t = F.bid - (F.G - 64); if (t >= 0 && t < 64) { __syncthreads(); rets_task(F, args, l, t); } }
        { const int t = F.bid - (F.G - 128); if (t >= 0 && t < 64) { __syncthreads(); mems_task(F, args, l, t); } }
        for (int t = F.bid; t < 65; t += F.G) { __syncthreads(); conv_task(F, args, l, t); }
        for (int t = F.bid; t < 1024; t += F.G) { __syncthreads(); ret1_task(F, args, l, t); }
        for (int t = F.bid; t < 256; t += F.G) { __syncthreads(); memp_task(F, args, l, t); }
        for (int t = F.bid; t < 256; t += F.G) { __syncthreads(); vtrans_task(F, t); }
        __syncthreads();
    }
    SEAM();
    for (int rep = 0; rep < REPS[6]; ++rep) { if (rep) SEAM(); FRESH();
        const int q = l * 64 + rep * 16;
        diff_lambda(F, l, F.lam, F.omi);
        for (int sr = 0; sr < SUBREP[0]; ++sr) for (;;) { const int t = wq_next(F, q + 5 + 32 * sr); if (t >= 64) break; diffs_task(F, args, l, t); }
        for (int sr = 0; sr < SUBREP[1]; ++sr) for (;;) { const int t = wq_next(F, q + 6 + 32 * sr); if (t >= 512) break; diffp_task(F, args, l, t); }
        for (int sr = 0; sr < SUBREP[2]; ++sr) for (int t = F.bid; t < 256; t += F.G) { __syncthreads(); ret2_task(F, args, l, t); }
    }
    SEAM();
    for (int rep = 0; rep < REPS[7]; ++rep) { if (rep) SEAM(); FRESH();
        for (int t = F.bid; t < 1024; t += F.G) { __syncthreads(); ret3_task(F, args, l, t); }
        __syncthreads();
    }
    SEAM();
    { FRESH();
        { pg8::Gemm g{Yb, (const bf16*)(wl + W_BR), D, D, 8, 128, 256 * D * 2}; pg8::StaticOrder S; S.init(MP / 256, D / 256, F.G, F.bid, 4, 512);
          pg8::EpiBranch E{GATE, Gb}; pg8::gemm_phase<pg8::EpiBranch, pg8::StaticOrder, true>(F.lds, F.tid, g, S, E); }
        { pg8::Gemm g{Yb, (const bf16*)(wl + W_BR), D, D, 8, 128, 256 * D * 2}; pg8::StaticOrder S; S.init_splitk(4, D / 256, F.G, F.G - 1 - F.bid, 512, MP / 256);
          pg8::EpiBranchS E{GATE, (bf16*)(ws + WS_BRS)}; pg8::gemm_phase<pg8::EpiBranchS, pg8::StaticOrder, true>(F.lds, F.tid, g, S, E); } }
    SEAM();
    { FRESH();
        { pg8::Gemm g{Gb, (const bf16*)(wl + W_WO), D, D, D / 64, 128, 256 * D * 2}; pg8::StaticOrder S; S.init(MP / 256, D / 256, F.G, F.bid);
          pg8::EpiY E{GATE}; pg8::gemm_phase<pg8::EpiY, pg8::StaticOrder, true>(F.lds, F.tid, g, S, E); }
        { pg8::Gemm g{(const bf16*)(ws + WS_BRS), (const bf16*)(wl + W_WO), D, D, 8, 128, 256 * D * 2}; pg8::StaticOrder S; S.init_seg4(4, D / 256, F.G, F.G - 1 - F.bid, 512, 0);
          pg8::EpiSlab E{(float*)(ws + WS_SLAB)}; pg8::gemm_phase<pg8::EpiSlab, pg8::StaticOrder, true>(F.lds, F.tid, g, S, E); } }
    SEAM();
    { FRESH(); ln_phase<false>(F, XB, XB + (size_t)MP * D, GATE, nullptr, nullptr, XB, inp(F, I_LN2G) + (size_t)l * D, inp(F, I_LN2B) + (size_t)l * D, (const float*)(ws + WS_SLAB), 16, 1.0f); }
    SEAM();
}

__global__ void __launch_bounds__(512, 2) fwd_kernel(Args args) {
    extern __shared__ __attribute__((aligned(16))) unsigned char lds_raw[];
    Frame F;
    F.lds = (LAS unsigned char*)lds_raw; F.aux = F.lds + AUX_OFF; F.MISC = (volatile LAS unsigned*)(F.aux + AUX_MISC);
    F.tid = threadIdx.x; F.lane = F.tid & 63; F.wave = __builtin_amdgcn_readfirstlane(F.tid >> 6); F.G = gridDim.x; F.bid = blockIdx.x;
    F.ctl = (gu32*)(args.ws + WS_CTL);
    for (int u = F.tid; u < 64; u += 512) F.MISC[u] = 0u;
    if (F.tid == 0) { LAS unsigned long long* tb = (LAS unsigned long long*)(F.aux + AUX_TBL);
#pragma unroll
        for (int k = 0; k < 30; ++k) tb[k] = (unsigned long long)args.in[k];
        tb[30] = (unsigned long long)args.out; }
    __syncthreads();
    const XcdBarrier bar = xcd_barrier_post((unsigned*)(F.ctl + CW_BAR), F.MISC + 8);
    { PHASE_LOCALS; for (int rep = 0; rep < REPS[0]; ++rep) { if (rep) SEAM(); const int l = 0; FRESH(); p0_prologue(F, args, ws); } SEAM(); }
    ffn_half(F, args, bar, 0, 0); { SEAM(); }
    mixer_block(F, args, bar, 0);
    ffn_half(F, args, bar, 0, 1); { SEAM(); }
    ffn_half(F, args, bar, 1, 0); { SEAM(); }
    mixer_block(F, args, bar, 1);
    ffn_half(F, args, bar, 1, 1);
}
#undef SEAM
#undef FRESH

extern "C" void kernel_launch(void* const* d_in, const int* in_sizes, int n_in, void* d_out, int out_size, void* d_ws, size_t ws_size, hipStream_t stream) {
    static int grid = 0;
    if (grid == 0) {
        if (n_in != 30 || (size_t)out_size != O_END || ws_size < WS_END) { fprintf(stderr, "kernel_launch: unexpected sizes: n_in %d out %d (want %zu) ws %zu (want >= %zu)\n", n_in, out_size, (size_t)O_END, ws_size, (size_t)WS_END); grid = -1; return; }
        int dev = 0, cus = 0, per_cu = 0;
        if (hipGetDevice(&dev) != hipSuccess || hipDeviceGetAttribute(&cus, hipDeviceAttributeMultiprocessorCount, dev) != hipSuccess) { grid = -1; return; }
        if (hipFuncSetAttribute((const void*)fwd_kernel, hipFuncAttributeMaxDynamicSharedMemorySize, LDS_BYTES) != hipSuccess) { fprintf(stderr, "kernel_launch: hipFuncSetAttribute failed\n"); grid = -1; return; }
        if (hipOccupancyMaxActiveBlocksPerMultiprocessor(&per_cu, (const void*)fwd_kernel, 512, LDS_BYTES) != hipSuccess || per_cu < 1) fprintf(stderr, "kernel_launch: occupancy query says %d\n", per_cu);
        (void)hipGetLastError();
        grid = cus;
    }
    if (grid < 0) return;
    (void)hipMemsetAsync((char*)d_ws + WS_CTL, 0, CTL_ZERO_BYTES, stream);
    Args a{};
    for (int i = 0; i < 30; ++i) a.in[i] = (const float*)d_in[i];
    a.out = (float*)d_out; a.ws = (unsigned char*)d_ws;
    a.ph_lo = 0; a.ph_hi = 0;
    hipLaunchKernelGGL(fwd_kernel, dim3(grid), dim3(512), LDS_BYTES, stream, a);
}
```
